# Optimizing an MI355X kernel written in HIP

```python
import functools
import jax, jax.numpy as jnp
from jax import lax
import numpy as np

D_MODEL = 1024
BATCH = 16
SEQ = 4096
DEPTH = 1
DEC_BATCH = 16
DEC_SEQ = 64
PAST_LEN = 1024

CHUNK = 64
HEAD_DIM = 64
A_Q_HEADS = 8
A_KV_HEADS = 2
A_GROUP = A_Q_HEADS // A_KV_HEADS
A_WINDOW = 128
A_BAND_CHUNKS = A_WINDOW // CHUNK + 1
A_REACH = (A_BAND_CHUNKS - 1) * CHUNK
B_HEADS = 4
B_PREV_CHUNKS = 8
B_BAND_CHUNKS = B_PREV_CHUNKS + 1
B_REACH = B_PREV_CHUNKS * CHUNK
REL_CLIP = 128
C_HEADS = 4
N_MEM = 256
FF_DIM = 2816
ROPE_THETA = 10000.0
EPS = 1e-6
NEG = -1e30
N_BRANCH = 3

A_Q = A_Q_HEADS * HEAD_DIM
A_KV = A_KV_HEADS * HEAD_DIM
B_W = B_HEADS * HEAD_DIM
C_W = C_HEADS * HEAD_DIM
IN_COLS = A_Q + 2 * A_KV + 3 * B_W + C_W
SPLITS = (A_Q, A_Q + A_KV, A_Q + 2 * A_KV, A_Q + 2 * A_KV + B_W,
          A_Q + 2 * A_KV + 2 * B_W, A_Q + 2 * A_KV + 3 * B_W)

kernel_name = 'hybrid_streaming_encoder_step'


def rmsnorm(x, g):
    xf = x.astype(jnp.float32)
    y = xf * lax.rsqrt(jnp.mean(xf * xf, axis=-1, keepdims=True) + EPS)
    return (y * g.astype(jnp.float32)).astype(x.dtype)


def swiglu(x, w_gate, w_up, w_down):
    return (jax.nn.silu(x @ w_gate) * (x @ w_up)) @ w_down


def rope(x, pos):
    half = HEAD_DIM // 2
    inv = ROPE_THETA ** (-jnp.arange(half, dtype=jnp.float32) / half)
    ang = pos.astype(jnp.float32)[:, None] * inv[None, :]
    cos = jnp.cos(ang)[None, :, None, :]
    sin = jnp.sin(ang)[None, :, None, :]
    xf = x.astype(jnp.float32)
    x1, x2 = xf[..., :half], xf[..., half:]
    return jnp.concatenate([x1 * cos - x2 * sin, x1 * sin + x2 * cos], axis=-1).astype(x.dtype)


def band_mask(q_pos, k_pos, band_chunks):
    qc = q_pos[:, None] // CHUNK
    kc = k_pos[None, :] // CHUNK
    return (k_pos[None, :] >= 0) & (kc <= qc) & (qc - kc < band_chunks)


def swa_sink_attend(q, k, v, q_pos, k_pos, sinks):
    b, sq = q.shape[:2]
    qg = q.reshape(b, sq, A_KV_HEADS, A_GROUP, HEAD_DIM)
    s = jnp.einsum('bqkgd,bskd->bkgqs', qg, k).astype(jnp.float32) * (HEAD_DIM ** -0.5)
    s = jnp.where(band_mask(q_pos, k_pos, A_BAND_CHUNKS), s, NEG)
    sink = sinks.astype(jnp.float32).reshape(1, A_KV_HEADS, A_GROUP, 1, 1)
    sink = jnp.broadcast_to(sink, s.shape[:-1] + (1,))
    p = jax.nn.softmax(jnp.concatenate([s, sink], axis=-1), axis=-1)[..., :-1]
    o = jnp.einsum('bkgqs,bskd->bqkgd', p.astype(v.dtype), v)
    return o.reshape(b, sq, A_Q)


def chunk_relpos_attend(q, k, v, q_pos, k_pos, rel_bias):
    b, sq = q.shape[:2]
    s = jnp.einsum('bqhd,bshd->bhqs', q, k).astype(jnp.float32) * (HEAD_DIM ** -0.5)
    rel = jnp.clip(q_pos[:, None] - k_pos[None, :], -REL_CLIP, REL_CLIP) + REL_CLIP
    s = s + rel_bias.astype(jnp.float32)[:, rel][None]
    s = jnp.where(band_mask(q_pos, k_pos, B_BAND_CHUNKS), s, NEG)
    p = jax.nn.softmax(s, axis=-1)
    o = jnp.einsum('bhqs,bshd->bqhd', p.astype(v.dtype), v)
    return o.reshape(b, sq, B_W)


def mem_attend(q, mk, mv):
    b, sq = q.shape[:2]
    s = jnp.einsum('bqhd,bmhd->bhqm', q, mk).astype(jnp.float32) * (HEAD_DIM ** -0.5)
    p = jax.nn.softmax(s, axis=-1)
    o = jnp.einsum('bhqm,bmhd->bqhd', p.astype(mv.dtype), mv)
    return o.reshape(b, sq, C_W)


def memory_kv(mem, g_mem, w_mem_kv, g_kc):
    m = rmsnorm(mem, g_mem) @ w_mem_kv
    b, n = m.shape[:2]
    mk = rmsnorm(m[..., :C_W].reshape(b, n, C_HEADS, HEAD_DIM), g_kc)
    mv = m[..., C_W:].reshape(b, n, C_HEADS, HEAD_DIM)
    return mk, mv


def sweep_chunks(core, reach, q, k, v):
    b, s = q.shape[:2]
    nc = s // CHUNK
    kp = jnp.pad(k, ((0, 0), (reach, 0), (0, 0), (0, 0)))
    vp = jnp.pad(v, ((0, 0), (reach, 0), (0, 0), (0, 0)))

    def one(c):
        start = c * CHUNK
        qc = lax.dynamic_slice_in_dim(q, start, CHUNK, axis=1)
        kc = lax.dynamic_slice_in_dim(kp, start, reach + CHUNK, axis=1)
        vc = lax.dynamic_slice_in_dim(vp, start, reach + CHUNK, axis=1)
        q_pos = start + jnp.arange(CHUNK, dtype=jnp.int32)
        k_pos = start - reach + jnp.arange(reach + CHUNK, dtype=jnp.int32)
        return core(qc, kc, vc, q_pos, k_pos)

    out = lax.map(one, jnp.arange(nc, dtype=jnp.int32))
    return out.transpose(1, 0, 2, 3).reshape(b, s, out.shape[-1])


def cached_attend(core, cache_k, cache_v, q, k, v):
    n_past = cache_k.shape[1]
    k_all = jnp.concatenate([cache_k, k], axis=1)
    v_all = jnp.concatenate([cache_v, v], axis=1)
    k_pos = jnp.arange(PAST_LEN - n_past, PAST_LEN + q.shape[1], dtype=jnp.int32)
    return core(q, k_all, v_all, k_pos[n_past:], k_pos)


def trunk_layer(x, pos, mem_k, mem_v, attn_a, attn_b, w):
    b, s, _ = x.shape
    x = x + 0.5 * swiglu(rmsnorm(x, w['g_ff1']), w['w_ff1_gate'], w['w_ff1_up'], w['w_ff1_down'])
    h = rmsnorm(x, w['g_mix'])
    qa, ka, va, qb, kb, vb, qc = jnp.split(h @ w['w_in'], SPLITS, axis=-1)
    heads = lambda t, n: t.reshape(b, s, n, HEAD_DIM)
    qa = rope(rmsnorm(heads(qa, A_Q_HEADS), w['g_qa']), pos)
    ka = rope(rmsnorm(heads(ka, A_KV_HEADS), w['g_ka']), pos)
    va = heads(va, A_KV_HEADS)
    qb = rmsnorm(heads(qb, B_HEADS), w['g_qb'])
    kb = rmsnorm(heads(kb, B_HEADS), w['g_kb'])
    vb = heads(vb, B_HEADS)
    qc = rmsnorm(heads(qc, C_HEADS), w['g_qc'])
    ya = attn_a(qa, ka, va)
    yb = attn_b(qb, kb, vb)
    yc = mem_attend(qc, mem_k, mem_v)
    gates = jax.nn.sigmoid((h @ w['w_gate'] + w['b_gate']).astype(jnp.float32))
    gates = gates.astype(x.dtype).reshape(b, s, N_BRANCH, D_MODEL)
    merged = (gates[..., 0, :] * (ya @ w['w_br_a']) + gates[..., 1, :] * (yb @ w['w_br_b'])
              + gates[..., 2, :] * (yc @ w['w_br_c']))
    x = x + merged @ w['w_out']
    x = x + 0.5 * swiglu(rmsnorm(x, w['g_ff2']), w['w_ff2_gate'], w['w_ff2_up'], w['w_ff2_down'])
    return rmsnorm(x, w['g_final']), (ka, va, kb, vb)


def setup_inputs(seed: int = 0) -> dict:
    key = jax.random.key(seed)
    ks = iter(jax.random.split(key, 48))
    nrm = lambda shape, scale: jax.random.normal(next(ks), shape, jnp.float32) * scale
    gain = lambda shape: 1.0 + nrm(shape, 0.01)
    L = DEPTH
    na = min(A_REACH, PAST_LEN)
    nb = min(B_REACH, PAST_LEN)
    return {
        'x_prompt': nrm((BATCH, SEQ, D_MODEL), 1.0),
        'x_sample': nrm((DEC_BATCH, DEC_SEQ, D_MODEL), 1.0),
        'cache_a_k': nrm((L, DEC_BATCH, na, A_KV_HEADS, HEAD_DIM), 1.0),
        'cache_a_v': nrm((L, DEC_BATCH, na, A_KV_HEADS, HEAD_DIM), 1.0),
        'cache_b_k': nrm((L, DEC_BATCH, nb, B_HEADS, HEAD_DIM), 1.0),
        'cache_b_v': nrm((L, DEC_BATCH, nb, B_HEADS, HEAD_DIM), 1.0),
        'cache_mem_k': nrm((L, DEC_BATCH, N_MEM, C_HEADS, HEAD_DIM), 1.0),
        'cache_mem_v': nrm((L, DEC_BATCH, N_MEM, C_HEADS, HEAD_DIM), 1.0),
        'mem_prompt': nrm((BATCH, N_MEM, D_MODEL), 1.0),
        'g_ff1': gain((L, D_MODEL)),
        'w_ff1_gate': nrm((L, D_MODEL, FF_DIM), D_MODEL ** -0.5),
        'w_ff1_up': nrm((L, D_MODEL, FF_DIM), D_MODEL ** -0.5),
        'w_ff1_down': nrm((L, FF_DIM, D_MODEL), FF_DIM ** -0.5),
        'g_mix': gain((L, D_MODEL)),
        'w_in': nrm((L, D_MODEL, IN_COLS), D_MODEL ** -0.5),
        'g_qa': gain((L, HEAD_DIM)),
        'g_ka': gain((L, HEAD_DIM)),
        'sinks_a': nrm((L, A_Q_HEADS), 0.5),
        'g_qb': gain((L, HEAD_DIM)),
        'g_kb': gain((L, HEAD_DIM)),
        'rel_bias_b': nrm((L, B_HEADS, 2 * REL_CLIP + 1), 0.1),
        'g_qc': gain((L, HEAD_DIM)),
        'g_mem': gain((L, D_MODEL)),
        'w_mem_kv': nrm((L, D_MODEL, 2 * C_W), D_MODEL ** -0.5),
        'g_kc': gain((L, HEAD_DIM)),
        'w_gate': nrm((L, D_MODEL, N_BRANCH * D_MODEL), D_MODEL ** -0.5),
        'b_gate': nrm((L, N_BRANCH * D_MODEL), 0.01),
        'w_br_a': nrm((L, A_Q, D_MODEL), A_Q ** -0.5),
        'w_br_b': nrm((L, B_W, D_MODEL), B_W ** -0.5),
        'w_br_c': nrm((L, C_W, D_MODEL), C_W ** -0.5),
        'w_out': nrm((L, D_MODEL, D_MODEL), D_MODEL ** -0.5),
        'g_ff2': gain((L, D_MODEL)),
        'w_ff2_gate': nrm((L, D_MODEL, FF_DIM), D_MODEL ** -0.5),
        'w_ff2_up': nrm((L, D_MODEL, FF_DIM), D_MODEL ** -0.5),
        'w_ff2_down': nrm((L, FF_DIM, D_MODEL), FF_DIM ** -0.5),
        'g_final': gain((L, D_MODEL)),
    }


def reference(x_prompt, x_sample, cache_a_k, cache_a_v, cache_b_k, cache_b_v, cache_mem_k, cache_mem_v,
              mem_prompt, g_ff1, w_ff1_gate, w_ff1_up, w_ff1_down, g_mix, w_in, g_qa, g_ka, sinks_a,
              g_qb, g_kb, rel_bias_b, g_qc, g_mem, w_mem_kv, g_kc, w_gate, b_gate, w_br_a, w_br_b,
              w_br_c, w_out, g_ff2, w_ff2_gate, w_ff2_up, w_ff2_down, g_final):
    s_p = x_prompt.shape[1]
    s_s = x_sample.shape[1]
    pos_p = jnp.arange(s_p, dtype=jnp.int32)
    pos_s = PAST_LEN + jnp.arange(s_s, dtype=jnp.int32)
    keep_a = min(A_REACH, s_p)
    keep_b = min(B_REACH, s_p)
    y_p, y_s = x_prompt, x_sample
    akp, avp, bkp, bvp, mkp, mvp, aks, avs, bks, bvs = ([] for _ in range(10))
    for l in range(DEPTH):
        w = dict(g_ff1=g_ff1[l], w_ff1_gate=w_ff1_gate[l], w_ff1_up=w_ff1_up[l], w_ff1_down=w_ff1_down[l],
                 g_mix=g_mix[l], w_in=w_in[l], g_qa=g_qa[l], g_ka=g_ka[l], g_qb=g_qb[l], g_kb=g_kb[l],
                 g_qc=g_qc[l], w_gate=w_gate[l], b_gate=b_gate[l], w_br_a=w_br_a[l], w_br_b=w_br_b[l],
                 w_br_c=w_br_c[l], w_out=w_out[l], g_ff2=g_ff2[l], w_ff2_gate=w_ff2_gate[l],
                 w_ff2_up=w_ff2_up[l], w_ff2_down=w_ff2_down[l], g_final=g_final[l])
        core_a = functools.partial(swa_sink_attend, sinks=sinks_a[l])
        core_b = functools.partial(chunk_relpos_attend, rel_bias=rel_bias_b[l])
        mk, mv = memory_kv(mem_prompt, g_mem[l], w_mem_kv[l], g_kc[l])
        y_p, (ka, va, kb, vb) = trunk_layer(
            y_p, pos_p, mk, mv,
            functools.partial(sweep_chunks, core_a, A_REACH),
            functools.partial(sweep_chunks, core_b, B_REACH), w)
        akp.append(ka[:, s_p - keep_a:]); avp.append(va[:, s_p - keep_a:])
        bkp.append(kb[:, s_p - keep_b:]); bvp.append(vb[:, s_p - keep_b:])
        mkp.append(mk); mvp.append(mv)
        y_s, (ka, va, kb, vb) = trunk_layer(
            y_s, pos_s, cache_mem_k[l], cache_mem_v[l],
            functools.partial(cached_attend, core_a, cache_a_k[l], cache_a_v[l]),
            functools.partial(cached_attend, core_b, cache_b_k[l], cache_b_v[l]), w)
        aks.append(ka); avs.append(va); bks.append(kb); bvs.append(vb)
    return (y_p, y_s, jnp.stack(akp), jnp.stack(avp), jnp.stack(bkp), jnp.stack(bvp),
            jnp.stack(mkp), jnp.stack(mvp), jnp.stack(aks), jnp.stack(avs), jnp.stack(bks), jnp.stack(bvs))
```

```cpp
#include <hip/hip_runtime.h>
#include <hip/hip_cooperative_groups.h>
#include <cstdio>
#include <cstdint>
namespace cg = cooperative_groups;
__device__ __forceinline__ int lane_id() { int l; asm volatile("v_mbcnt_lo_u32_b32 %0, -1, 0\n\tv_mbcnt_hi_u32_b32 %0, -1, %0" : "=v"(l)); return l; }
namespace pg8 {
#define PG8_LAS __attribute__((address_space(3)))
typedef unsigned short bf16_t;
typedef short bf16x8 __attribute__((ext_vector_type(8)));
typedef float f32x4 __attribute__((ext_vector_type(4)));
typedef unsigned u32x4 __attribute__((ext_vector_type(4)));
constexpr int BM = 256, BK = 64, HALF = 128, HTB = HALF * BK * 2  , STAGE_BYTES = 8 * HTB, NXCD = 8, WGM = 8;

__host__ __device__ __forceinline__ int lds_byte(int r, int c) { const int st = (r >> 4) * 2 + (c >> 5), rr = r & 15, cc = c & 31, ob = rr * 64 + cc * 2; return st * 1024 + (ob ^ (((ob >> 9) & 1) << 5)); }
__host__ __device__ __forceinline__ void stage_rc(int b, int& R, int& C) { const int st = b / 1024, sb = b % 1024, swz = sb ^ (((sb >> 9) & 1) << 5); R = (st >> 1) * 16 + swz / 64; C = (st & 1) * 32 + (swz % 64) / 2; }
__host__ __device__ __forceinline__ int perm32(int rho) { const int n = rho >> 4, i = rho & 15; return 8 * (i >> 2) + 4 * n + (i & 3); }

struct Unit { int pm, pn, ks; };
struct Gemm { const bf16_t* A; const bf16_t* Bt; int M, N, K, nt; };

struct StaticOrder {
    int nM, nN, nwg, G, c;
    __host__ __device__ void init(int M, int N, int G_, int c_) { nM = M / BM; nN = N / BM; nwg = nM * nN; G = G_; c = c_; }
    __host__ __device__ bool next(int i, Unit& u) const {
        const long L = (long)i * G + c; if (L >= nwg) return false;
        int wgid = (int)L; { const int q = nwg / NXCD, r = nwg % NXCD, xcd = wgid % NXCD, off = wgid / NXCD; wgid = (xcd < r ? xcd * (q + 1) : r * (q + 1) + (xcd - r) * q) + off; }
        const int nig = WGM * nN, gid = wgid / nig, fm = gid * WGM, gsz = (nM - fm) < WGM ? (nM - fm) : WGM;
        u.pm = fm + ((wgid % nig) % gsz); u.pn = (wgid % nig) / gsz; u.ks = 0; return true;
    }
    __device__ __forceinline__ void a_ready(const Unit&) const {}
    __device__ __forceinline__ void done(const Unit&) const {}
};

typedef float cvt_f32x2_t __attribute__((ext_vector_type(2))); typedef __bf16 cvt_bf16x2_t __attribute__((ext_vector_type(2)));
__device__ __forceinline__ unsigned cvt_pk_bf16(float lo, float hi) { const cvt_f32x2_t v = {lo, hi}; const cvt_bf16x2_t b = __builtin_convertvector(v, cvt_bf16x2_t); return __builtin_bit_cast(unsigned, b); }
template <class Epi, class Sched, bool ALIGN_EPI = false, bool SP2 = false>
__device__ __forceinline__ void gemm_phase(PG8_LAS unsigned char* lds, const Gemm g, const Sched& S, const Epi& E, int wave_s) {
    int tid_o = wave_s * 64 + lane_id(); asm volatile("" : "+v"(tid_o));
    const int tid = tid_o, wid = __builtin_amdgcn_readfirstlane(tid >> 6), lane = tid & 63, wr = wid >> 2, wc = wid & 3, fr = lane & 15, fq = lane >> 4;
    const int K = g.K, nt = g.nt;
    unsigned voffA[2], voffB[2];
#pragma unroll
    for (int i = 0; i < 2; ++i) { int R, C; stage_rc(tid * 16 + i * 8192, R, C); const int Rb = Epi::PERM ? ((R & ~31) + perm32(R & 31)) : R;
        voffA[i] = (unsigned)(R * K + C) * 2u; voffB[i] = (unsigned)(Rb * K + C) * 2u; }
    const size_t kstep = (size_t)(BK * 2);
    const size_t hstep = (size_t)HALF * K * 2;
    const size_t tstep = 2 * hstep;
    const unsigned ldsw = (unsigned)wid * 1024u;
    const int aoff = lds_byte(wr * 64 + fr, fq * 8), boff = lds_byte(wc * 32 + fr, fq * 8);
#define PG8_SA(b, h) (((b) * 2 + (h)) * HTB)
#define PG8_SB(b, h) ((4 + (b) * 2 + (h)) * HTB)
#define PG8_STAGE(bufoff, gbase, voff) do { _Pragma("unroll") for (int _i = 0; _i < 2; ++_i) \
        __builtin_amdgcn_global_load_lds((const unsigned*)((const char*)(gbase) + (voff)[_i]), (PG8_LAS unsigned*)(lds + (bufoff) + ldsw + _i * 8192), 16, 0, 0); } while (0)
#define PG8_LDA(dst, b, h) do { _Pragma("unroll") for (int m = 0; m < 4; ++m) _Pragma("unroll") for (int k = 0; k < 2; ++k) dst[m][k] = *(const PG8_LAS bf16x8*)(lds + PG8_SA(b, h) + aoff + m * 2048 + k * 1024); } while (0)
#define PG8_LDB(dst, b, h) do { _Pragma("unroll") for (int n = 0; n < 2; ++n) _Pragma("unroll") for (int k = 0; k < 2; ++k) dst[n][k] = *(const PG8_LAS bf16x8*)(lds + PG8_SB(b, h) + boff + n * 2048 + k * 1024); } while (0)
#define PG8_MMA(ai, bj, At, Bt) do { __builtin_amdgcn_s_setprio(1); _Pragma("unroll") for (int m = 0; m < 4; ++m) _Pragma("unroll") for (int n = 0; n < 2; ++n) _Pragma("unroll") for (int k = 0; k < 2; ++k) \
        acc[ai][bj][m][n] = __builtin_amdgcn_mfma_f32_16x16x32_bf16(Bt[n][k], At[m][k], acc[ai][bj][m][n], 0, 0, 0); __builtin_amdgcn_s_setprio(0); } while (0)
#define PG8_WAIT_V(n) asm volatile("s_waitcnt vmcnt(" #n ")" ::: "memory")
#define PG8_WAIT_L(n) asm volatile("s_waitcnt lgkmcnt(" #n ")" ::: "memory")
#define PG8_BAR __builtin_amdgcn_s_barrier()
#define PG8_SCHED __builtin_amdgcn_sched_barrier(0)
    Unit cur, nxt; int ui = 0;
    int rs_t = 2; asm volatile("" : "+s"(rs_t));
    if (!S.next(0, cur)) return;
    f32x4 acc[2][2][4][2];
#pragma unroll
    for (int a = 0; a < 2; ++a)
#pragma unroll
        for (int b = 0; b < 2; ++b)
#pragma unroll
            for (int m = 0; m < 4; ++m)
#pragma unroll
                for (int n = 0; n < 2; ++n) acc[a][b][m][n] = (f32x4){0.f, 0.f, 0.f, 0.f};
    bf16x8 At[4][2], B0[2][2], B1[2][2];
    const size_t sstep = (size_t)nt * kstep;
    const char* cA = (const char*)g.A + (size_t)cur.pm * tstep + (size_t)cur.ks * sstep; const char* cB = (const char*)g.Bt + (size_t)cur.pn * tstep + (size_t)cur.ks * sstep;
    S.a_ready(cur);
    if constexpr (SP2) {
        PG8_STAGE(PG8_SB(0, 0), cB, voffB); PG8_STAGE(PG8_SB(0, 1), cB + hstep, voffB); PG8_STAGE(PG8_SA(0, 0), cA, voffA); PG8_STAGE(PG8_SA(0, 1), cA + hstep, voffA);
        if (wr == 1) PG8_BAR;
        PG8_WAIT_V(2); PG8_BAR;
        PG8_STAGE(PG8_SB(1, 0), cB + kstep, voffB); PG8_STAGE(PG8_SA(1, 0), cA + kstep, voffA); PG8_STAGE(PG8_SB(1, 1), cB + hstep + kstep, voffB);
        PG8_WAIT_V(6); PG8_BAR;
    } else {
        PG8_STAGE(PG8_SB(0, 0), cB, voffB); PG8_STAGE(PG8_SA(0, 0), cA, voffA); PG8_STAGE(PG8_SB(0, 1), cB + hstep, voffB); PG8_STAGE(PG8_SA(0, 1), cA + hstep, voffA);
        if (wr == 1) PG8_BAR;
        PG8_WAIT_V(4); PG8_BAR;
        PG8_STAGE(PG8_SB(1, 0), cB + kstep, voffB); PG8_STAGE(PG8_SA(1, 0), cA + kstep, voffA); PG8_STAGE(PG8_SB(1, 1), cB + hstep + kstep, voffB);
        PG8_WAIT_V(6); PG8_BAR;
    }
    for (;;) {
        const bool has_next = S.next(ui + 1, nxt);
        const char* nA = has_next ? (const char*)g.A + (size_t)nxt.pm * tstep + (size_t)nxt.ks * sstep : cA; const char* nB = has_next ? (const char*)g.Bt + (size_t)nxt.pn * tstep + (size_t)nxt.ks * sstep : cB;
        for (int t = 0; t < nt; t += 2) {
            if constexpr (Epi::HOOK) { if (t == 8 || t == 12) E.hook(acc, cur, t, wr, wc, fr, fq); }
            typename Epi::RsT rsr;
            if constexpr (Epi::RSLDS) { if (t == rs_t) E.rs_issue(cur, wid, lane, rsr); }
            const bool last = (t == nt - 2);
            const char* a1 = cA + (size_t)(t + 1) * kstep;
            const char* a2 = last ? nA : cA + (size_t)(t + 2) * kstep; const char* b2 = last ? nB : cB + (size_t)(t + 2) * kstep;
            const char* a3 = a2 + kstep; const char* b3 = b2 + kstep;
            if (last && has_next) S.a_ready(nxt);
            if constexpr (SP2) {
            PG8_LDB(B0, 0, 0); PG8_LDB(B1, 0, 1); PG8_SCHED; PG8_LDA(At, 0, 0); PG8_STAGE(PG8_SA(1, 1), a1 + hstep, voffA);
            PG8_WAIT_V(8); PG8_WAIT_L(0); PG8_BAR; PG8_MMA(0, 0, At, B0); PG8_MMA(0, 1, At, B1); PG8_BAR; PG8_SCHED;
            PG8_LDA(At, 0, 1); PG8_STAGE(PG8_SB(0, 0), b2, voffB); PG8_STAGE(PG8_SB(0, 1), b2 + hstep, voffB); PG8_STAGE(PG8_SA(0, 0), a2, voffA);
            PG8_WAIT_V(8); PG8_WAIT_L(0); PG8_BAR; PG8_MMA(1, 0, At, B0); PG8_MMA(1, 1, At, B1); PG8_BAR; PG8_SCHED;
            PG8_LDB(B0, 1, 0); PG8_LDB(B1, 1, 1); PG8_SCHED; PG8_LDA(At, 1, 0); PG8_STAGE(PG8_SA(0, 1), a2 + hstep, voffA);
            PG8_WAIT_V(8); PG8_WAIT_L(0); PG8_BAR; PG8_MMA(0, 0, At, B0); PG8_MMA(0, 1, At, B1); PG8_BAR; PG8_SCHED;
            PG8_LDA(At, 1, 1); PG8_STAGE(PG8_SB(1, 0), b3, voffB); PG8_STAGE(PG8_SB(1, 1), b3 + hstep, voffB); PG8_STAGE(PG8_SA(1, 0), a3, voffA);
            PG8_WAIT_V(8); PG8_WAIT_L(0); PG8_BAR; PG8_MMA(1, 0, At, B0); PG8_MMA(1, 1, At, B1); PG8_BAR; PG8_SCHED;
            } else {
            PG8_LDB(B0, 0, 0); PG8_SCHED; PG8_LDA(At, 0, 0); PG8_STAGE(PG8_SA(1, 1), a1 + hstep, voffA);
            PG8_WAIT_L(8); PG8_BAR; PG8_WAIT_L(0); PG8_MMA(0, 0, At, B0); PG8_BAR; PG8_SCHED;
            PG8_LDB(B1, 0, 1); PG8_STAGE(PG8_SB(0, 0), b2, voffB);
            PG8_BAR; PG8_WAIT_L(0); PG8_MMA(0, 1, At, B1); PG8_BAR;
            PG8_LDA(At, 0, 1); PG8_STAGE(PG8_SA(0, 0), a2, voffA);
            PG8_BAR; PG8_WAIT_L(0); PG8_MMA(1, 0, At, B0); PG8_BAR; PG8_SCHED;
            PG8_STAGE(PG8_SB(0, 1), b2 + hstep, voffB);
            PG8_WAIT_V(6); PG8_BAR; PG8_MMA(1, 1, At, B1); PG8_BAR;
            PG8_LDB(B0, 1, 0); PG8_SCHED; PG8_LDA(At, 1, 0); PG8_STAGE(PG8_SA(0, 1), a2 + hstep, voffA);
            PG8_WAIT_L(8); PG8_BAR; PG8_WAIT_L(0); PG8_MMA(0, 0, At, B0); PG8_BAR; PG8_SCHED;
            PG8_LDB(B1, 1, 1); PG8_STAGE(PG8_SB(1, 0), b3, voffB);
            PG8_BAR; PG8_WAIT_L(0); PG8_MMA(0, 1, At, B1); PG8_BAR;
            PG8_LDA(At, 1, 1); PG8_STAGE(PG8_SA(1, 0), a3, voffA);
            PG8_BAR; PG8_WAIT_L(0); PG8_MMA(1, 0, At, B0); PG8_BAR; PG8_SCHED;
            PG8_STAGE(PG8_SB(1, 1), b3 + hstep, voffB);
            PG8_WAIT_V(6); PG8_BAR; PG8_MMA(1, 1, At, B1); PG8_BAR;
            }
            if constexpr (Epi::RSLDS) { if (t == rs_t) E.rs_finish(lds, wid, lane, rsr); }
        }
        if constexpr (ALIGN_EPI) { if (wr == 0) PG8_BAR; }
        if constexpr (!Epi::AFTER_DRAIN) { E(acc, cur, wr, wc, fr, fq); S.done(cur); }
        if (!has_next) break;
#pragma unroll
        for (int a = 0; a < 2; ++a)
#pragma unroll
            for (int b = 0; b < 2; ++b)
#pragma unroll
                for (int m = 0; m < 4; ++m)
#pragma unroll
                    for (int n = 0; n < 2; ++n) acc[a][b][m][n] = (f32x4){0.f, 0.f, 0.f, 0.f};
        cur = nxt; cA = nA; cB = nB; ++ui;
        if constexpr (ALIGN_EPI) { if (wr == 1) PG8_BAR; }
    }
    PG8_WAIT_V(0);
    if constexpr (!ALIGN_EPI) { if (wr == 0) PG8_BAR; }
    PG8_BAR;
    if constexpr (Epi::AFTER_DRAIN) { E.fused(acc, cur, wr, wc, fr, fq, lds, wid, lane); S.done(cur); }
#undef PG8_SA
#undef PG8_SB
#undef PG8_STAGE
#undef PG8_LDA
#undef PG8_LDB
#undef PG8_MMA
#undef PG8_WAIT_V
#undef PG8_WAIT_L
#undef PG8_BAR
#undef PG8_SCHED
}
}
#ifndef PG8_SP2
#define PG8_SP2 true
#endif
#ifndef PG8_ALIGN
#define PG8_ALIGN true
#endif
#ifndef SKIP_UP
#define SKIP_UP 0
#endif
#ifndef SKIP_DN
#define SKIP_DN 0
#endif
#ifndef SKIP_IN
#define SKIP_IN 0
#endif
#ifndef SKIP_AT
#define SKIP_AT 0
#endif
#ifndef SKIP_BR
#define SKIP_BR 0
#endif
#ifndef SKIP_OUT
#define SKIP_OUT 0
#endif
#ifndef SKIP_P0
#define SKIP_P0 0
#endif
#ifndef PROBE_DUP
#define PROBE_DUP 0
#endif
#ifndef MK_MULTI
#define MK_MULTI 0
#endif

#define LAS __attribute__((address_space(3)))
typedef unsigned short bf16;
typedef short bf16x8 __attribute__((ext_vector_type(8)));
typedef float f32x4 __attribute__((ext_vector_type(4)));
typedef float f32x2 __attribute__((ext_vector_type(2)));
typedef float f32x16 __attribute__((ext_vector_type(16)));
typedef unsigned u32x4 __attribute__((ext_vector_type(4)));
typedef unsigned u32x2 __attribute__((ext_vector_type(2)));

constexpr int D = 1024, FF = 2816, MP = 65536, MSAMP = 1024, M = MP + MSAMP, MMEM = 4096, MA = M + MMEM;
constexpr int N_UP = 2 * FF, N_IN = 4864, N_INALL = 5376;
constexpr float EPS = 1e-6f, LOG2E = 1.4426950408889634f, C2 = 0.125f * 1.4426950408889634f;
constexpr int NWAVES = 8, NTHREADS = 512;
constexpr int RING_BYTES = 131072, BIAS_OFF = RING_BYTES + 1024, LDS_BYTES = 147456;

constexpr size_t MiB = 1u << 20;
constexpr size_t WS_ROPE = 1 * MiB, WS_SSQ = 2 * MiB, WS_WUP1 = 8 * MiB, WS_WDN1 = 20 * MiB, WS_WUP2 = 26 * MiB, WS_WDN2 = 38 * MiB, WS_WIN = 44 * MiB,
                 WS_WBR = 56 * MiB, WS_WOUT = 58 * MiB, WS_KAS = 60 * MiB, WS_VTAS = 61 * MiB, WS_KBS = 62 * MiB, WS_VTBS = 67 * MiB, WS_MKS = 72 * MiB,
                 WS_MVTS = 74 * MiB, WS_MKP = 76 * MiB, WS_MVTP = 78 * MiB, WS_XB = 80 * MiB, WS_KAP = 218 * MiB, WS_VTAP = 234 * MiB, WS_KBP = 250 * MiB,
                 WS_VTBP = 282 * MiB, WS_Q = 314 * MiB, WS_Y = 444 * MiB, WS_H = 574 * MiB, WS_PART = 964 * MiB, WS_END = 1010 * MiB;
static_assert(WS_XB + (size_t)MA * D * 2 <= WS_KAP && WS_Q + (size_t)M * D * 2 <= WS_Y && WS_Y + (size_t)M * D * 2 <= WS_H && WS_H + (size_t)M * 3072 * 2 <= WS_PART && WS_PART + (size_t)11 * 1024 * 1024 * 4 <= WS_END, "ws map");
constexpr size_t OFF_AKP = 68157440, OFF_AVP = 68419584, OFF_BKP = 68681728, OFF_BVP = 70778880, OFF_MKP = 72876032, OFF_MVP = 73924608,
                 OFF_AKS = 74973184, OFF_AVS = 75104256, OFF_BKS = 75235328, OFF_BVS = 75497472;

using pg8::Unit;
using pg8::cvt_pk_bf16;

__device__ __forceinline__ float row_rs(const float* ssq, int row) {
    const f32x4* p = (const f32x4*)(ssq + (size_t)row * 16);
    const f32x4 a = p[0], b = p[1], c = p[2], d = p[3];
    const f32x4 s = (a + b) + (c + d);
    return rsqrtf(((s[0] + s[1]) + (s[2] + s[3])) * (1.0f / 1024.0f) + EPS);
}
__device__ __forceinline__ void load_rs8(const float* ssq, int row0, int fq, float (&rs)[2][4]) {
    f32x4 t[2][4];
#pragma unroll
    for (int ai = 0; ai < 2; ++ai)
#pragma unroll
        for (int m = 0; m < 4; ++m) t[ai][m] = *(const f32x4*)(ssq + (size_t)(row0 + ai * 128 + m * 16) * 16 + 4 * fq);
#pragma unroll
    for (int ai = 0; ai < 2; ++ai)
#pragma unroll
        for (int m = 0; m < 4; ++m) { float s_ = (t[ai][m][0] + t[ai][m][1]) + (t[ai][m][2] + t[ai][m][3]); s_ += __shfl_xor(s_, 16); s_ += __shfl_xor(s_, 32);
            rs[ai][m] = rsqrtf(s_ * (1.0f / 1024.0f) + EPS); }
}
constexpr int RS_LDS_OFF = 131072 + 6144;
struct NoRs {};
struct RsReg { f32x4 a, b; };
__device__ __forceinline__ void rs_issue_regs(const float* ssq, int pm, int wid, int lane, RsReg& r) {
    const f32x4* p = (const f32x4*)(ssq + (size_t)(pm * 256 + 32 * wid + (lane >> 1)) * 16 + 8 * (lane & 1)); r.a = p[0]; r.b = p[1];
}
__device__ __forceinline__ void rs_finish_lds(__attribute__((address_space(3))) unsigned char* lds, int wid, int lane, const RsReg& r) {
    float s_ = ((r.a[0] + r.a[1]) + (r.a[2] + r.a[3])) + ((r.b[0] + r.b[1]) + (r.b[2] + r.b[3])); s_ += __shfl_xor(s_, 1);
    if (!(lane & 1)) ((__attribute__((address_space(3))) float*)(lds + RS_LDS_OFF))[32 * wid + (lane >> 1)] = rsqrtf(s_ * (1.0f / 1024.0f) + EPS);
}
__device__ __forceinline__ void rs_fill_lds(const float* ssq, int pm, __attribute__((address_space(3))) unsigned char* lds, int wid, int lane) {
    const int r = 32 * wid + (lane >> 1);
    const f32x4* p = (const f32x4*)(ssq + (size_t)(pm * 256 + r) * 16 + 8 * (lane & 1));
    const f32x4 a = p[0], b = p[1];
    float s_ = ((a[0] + a[1]) + (a[2] + a[3])) + ((b[0] + b[1]) + (b[2] + b[3])); s_ += __shfl_xor(s_, 1);
    if (!(lane & 1)) ((__attribute__((address_space(3))) float*)(lds + RS_LDS_OFF))[r] = rsqrtf(s_ * (1.0f / 1024.0f) + EPS);
}
__device__ __forceinline__ void rs_read_lds(int wr, int fr, float (&rs)[2][4]) {
    const __attribute__((address_space(3))) float* t = (const __attribute__((address_space(3))) float*)(uintptr_t)RS_LDS_OFF;
#pragma unroll
    for (int ai = 0; ai < 2; ++ai)
#pragma unroll
        for (int m = 0; m < 4; ++m) rs[ai][m] = t[ai * 128 + wr * 64 + m * 16 + fr];
}
__device__ __forceinline__ float fq_sum(float v) {
    const auto a = __builtin_amdgcn_permlane16_swap(__float_as_uint(v), __float_as_uint(v), false, false);
    const float s1 = __uint_as_float(a[0]) + __uint_as_float(a[1]);
    const auto b = __builtin_amdgcn_permlane32_swap(__float_as_uint(s1), __float_as_uint(s1), false, false);
    return __uint_as_float(b[0]) + __uint_as_float(b[1]);
}
__device__ __forceinline__ float bf_lo(unsigned w) { return __uint_as_float(w << 16); }
__device__ __forceinline__ float bf_hi(unsigned w) { return __uint_as_float(w & 0xffff0000u); }
__device__ __forceinline__ int kf_off(int t, int d) { return ((t >> 5) * 4 + (d >> 4)) * 512 + ((((d >> 3) & 1) * 32) + (t & 31)) * 8 + (d & 7); }
__device__ __forceinline__ int vf_off(int t, int d) { const int kvl = t & 15, hi = (kvl >> 2) & 1, e = ((kvl >> 3) << 2) | (kvl & 3);
    return (((t >> 6) * 2 + (d >> 5)) * 4 + ((t >> 4) & 3)) * 512 + (hi * 32 + (d & 31)) * 8 + e; }
__device__ __forceinline__ size_t gate_off8(int pm, int t, int ai, int m, int bj, int tid) { return ((((size_t)pm * 12 + t) * 16 + (ai * 4 + m) * 2 + bj) * 512 + tid) * 8; }
__device__ __forceinline__ float ub(unsigned w, int k) { return (float)((w >> (8 * k)) & 0xffu); }
__device__ __forceinline__ float sigm(float z) { return __builtin_amdgcn_rcpf(1.0f + __builtin_amdgcn_exp2f(-z * LOG2E)); }

struct EpiUp {
    static constexpr bool PERM = true, AFTER_DRAIN = false, HOOK = false, RSLDS = true;
    unsigned char* ws;
    typedef RsReg RsT;
    __device__ __forceinline__ void rs_issue(const Unit& u, int wid, int lane, RsReg& r) const { rs_issue_regs((const float*)(ws + WS_SSQ), u.pm, wid, lane, r); }
    __device__ __forceinline__ void rs_finish(__attribute__((address_space(3))) unsigned char* lds, int wid, int lane, const RsReg& r) const { rs_finish_lds(lds, wid, lane, r); }
    __device__ __forceinline__ void operator()(const f32x4 (&acc)[2][2][4][2], const Unit& u, int wr, int wc, int fr, int fq) const {
        const float* ssq = (const float*)(ws + WS_SSQ); bf16* H = (bf16*)(ws + WS_H);
        const int row0 = u.pm * 256 + wr * 64 + fr, col0 = u.pn * 128 + wc * 32 + 8 * fq;
        float rsv[2][4]; rs_read_lds(wr, fr, rsv); (void)ssq;
#pragma unroll
        for (int ai = 0; ai < 2; ++ai)
#pragma unroll
            for (int m = 0; m < 4; ++m) {
                const int row = row0 + ai * 128 + m * 16; const float rs = rsv[ai][m];
                const float k1 = -rs * LOG2E, k2 = rs * rs;
                float h[8];
#pragma unroll
                for (int n = 0; n < 2; ++n)
#pragma unroll
                    for (int e2 = 0; e2 < 2; ++e2) {
                        const f32x2 ag = (f32x2){acc[ai][0][m][n][2 * e2], acc[ai][0][m][n][2 * e2 + 1]}, au = (f32x2){acc[ai][1][m][n][2 * e2], acc[ai][1][m][n][2 * e2 + 1]};
                        const f32x2 ea = ag * k1; f32x2 ex; ex.x = __builtin_amdgcn_exp2f(ea.x); ex.y = __builtin_amdgcn_exp2f(ea.y);
                        const f32x2 den = ex + 1.0f; f32x2 sg; sg.x = __builtin_amdgcn_rcpf(den.x); sg.y = __builtin_amdgcn_rcpf(den.y);
                        const f32x2 hh = ((ag * au) * k2) * sg;
                        h[4 * n + 2 * e2] = hh.x; h[4 * n + 2 * e2 + 1] = hh.y; }
                u32x4 w; w.x = cvt_pk_bf16(h[0], h[1]); w.y = cvt_pk_bf16(h[2], h[3]); w.z = cvt_pk_bf16(h[4], h[5]); w.w = cvt_pk_bf16(h[6], h[7]);
                __builtin_nontemporal_store(w, (u32x4*)(H + (size_t)row * FF + col0));
            }
    }
};
struct EpiRes {
    static constexpr bool PERM = true, AFTER_DRAIN = false, HOOK = false, RSLDS = false;
    typedef NoRs RsT;
    unsigned char* ws; float scale;
    __device__ __forceinline__ void operator()(const f32x4 (&acc)[2][2][4][2], const Unit& u, int wr, int wc, int fr, int fq) const {
        bf16* xb = (bf16*)(ws + WS_XB); float* ssq = (float*)(ws + WS_SSQ);
        const int row0 = u.pm * 256 + wr * 64 + fr, col0 = u.pn * 256 + wc * 32 + 8 * fq;
        u32x4 old[2][4][2];
#pragma unroll
        for (int ai = 0; ai < 2; ++ai)
#pragma unroll
            for (int m = 0; m < 4; ++m)
#pragma unroll
                for (int bj = 0; bj < 2; ++bj) old[ai][m][bj] = *(const u32x4*)(xb + (size_t)(row0 + ai * 128 + m * 16) * D + col0 + bj * 128);
#pragma unroll
        for (int ai = 0; ai < 2; ++ai)
#pragma unroll
            for (int m = 0; m < 4; ++m) {
                const int row = row0 + ai * 128 + m * 16; f32x2 ss2 = (f32x2){0.f, 0.f};
#pragma unroll
                for (int bj = 0; bj < 2; ++bj) { const u32x4 o = old[ai][m][bj]; u32x4 w;
#pragma unroll
                    for (int j = 0; j < 4; ++j) {
                        const f32x2 a2 = (f32x2){acc[ai][bj][m][j >> 1][(j & 1) * 2], acc[ai][bj][m][j >> 1][(j & 1) * 2 + 1]};
                        const f32x2 n2 = a2 * scale + (f32x2){bf_lo(o[j]), bf_hi(o[j])};
                        ss2 += n2 * n2; w[j] = cvt_pk_bf16(n2.x, n2.y); }
                    *(u32x4*)(xb + (size_t)row * D + col0 + bj * 128) = w; }
                float ss = ss2.x + ss2.y;
                ss = fq_sum(ss);
                if (fq == 0) ssq[(size_t)row * 16 + u.pn * 4 + wc] = ss;
            }
    }
};
struct EpiIn {
    static constexpr bool PERM = true, AFTER_DRAIN = false, HOOK = false, RSLDS = true;
    const float* const* in; unsigned char* ws; float* out;
    typedef RsReg RsT;
    __device__ __forceinline__ void rs_issue(const Unit& u, int wid, int lane, RsReg& r) const { rs_issue_regs((const float*)(ws + WS_SSQ), u.pm, wid, lane, r); }
    __device__ __forceinline__ void rs_finish(__attribute__((address_space(3))) unsigned char* lds, int wid, int lane, const RsReg& r) const { rs_finish_lds(lds, wid, lane, r); }
    __device__ __forceinline__ void operator()(const f32x4 (&acc)[2][2][4][2], const Unit& u, int wr, int wc, int fr, int fq) const {
        const float* ssq = (const float*)(ws + WS_SSQ); const f32x2* rope = (const f32x2*)(ws + WS_ROPE);
        bf16* Q = (bf16*)(ws + WS_Q); bf16* G = (bf16*)(ws + WS_H);
        int pm_o = u.pm, pn_o = u.pn; asm volatile("" : "+s"(pm_o), "+s"(pn_o), "+s"(wc), "+s"(wr), "+v"(fr), "+v"(fq));
        const int pm = pm_o, pn = pn_o, row0 = pm * 256 + wr * 64 + fr;
        float rsv[2][4]; rs_read_lds(wr, fr, rsv); (void)ssq;
        if (pn >= 7 && pn < 19) {
            const int col0 = (pn - 7) * 256 + wc * 32 + 8 * fq;
            const float* b_gate = in[26];
            float bb[2][8];
#pragma unroll
            for (int bj = 0; bj < 2; ++bj)
#pragma unroll
                for (int i = 0; i < 8; ++i) bb[bj][i] = -LOG2E * b_gate[col0 + bj * 128 + i];
#pragma unroll
            for (int ai = 0; ai < 2; ++ai)
#pragma unroll
                for (int m = 0; m < 4; ++m) {
                    const int row = row0 + ai * 128 + m * 16; const float k1 = -LOG2E * rsv[ai][m];
#pragma unroll
                    for (int bj = 0; bj < 2; ++bj) { unsigned q[8];
#pragma unroll
                        for (int i2 = 0; i2 < 4; ++i2) {
                            const f32x2 a2 = (f32x2){acc[ai][bj][m][i2 >> 1][(i2 & 1) * 2], acc[ai][bj][m][i2 >> 1][(i2 & 1) * 2 + 1]};
                            const f32x2 ez = a2 * k1 + (f32x2){bb[bj][2 * i2], bb[bj][2 * i2 + 1]};
                            f32x2 ex; ex.x = __builtin_amdgcn_exp2f(ez.x); ex.y = __builtin_amdgcn_exp2f(ez.y);
                            const f32x2 den = ex + 1.0f; f32x2 sg; sg.x = __builtin_amdgcn_rcpf(den.x); sg.y = __builtin_amdgcn_rcpf(den.y);
                            const f32x2 qf = sg * 255.0f + 0.5f;
                            const unsigned q0 = (unsigned)qf.x, q1 = (unsigned)qf.y; q[2 * i2] = q0 < 1u ? 1u : q0; q[2 * i2 + 1] = q1 < 1u ? 1u : q1; }
                        u32x2 w; w.x = q[0] | (q[1] << 8) | (q[2] << 16) | (q[3] << 24); w.y = q[4] | (q[5] << 8) | (q[6] << 16) | (q[7] << 24);
                        __builtin_nontemporal_store(w, (u32x2*)((unsigned char*)G + gate_off8(pm, pn - 7, ai, m, bj, (wr * 4 + wc) * 64 + fq * 16 + fr))); (void)row; }
                }
            return;
        }
        int mode, mixer = 0, hh = wc, qcol = 0, gidx = -1; bool rope_on = false;
        if (pn <= 1)       { mode = 0; gidx = 15; rope_on = true; qcol = (4 * pn + wc) * 64; }
        else if (pn == 2)  { mixer = 0; if (wc < 2) { mode = 1; gidx = 16; rope_on = true; hh = wc; } else { mode = 2; hh = wc - 2; } }
        else if (pn == 3)  { mode = 0; gidx = 18; qcol = 512 + wc * 64; }
        else if (pn == 4)  { mode = 1; gidx = 19; mixer = 1; }
        else if (pn == 5)  { mode = 2; mixer = 1; }
        else if (pn == 6)  { mode = 0; gidx = 21; qcol = 768 + wc * 64; }
        else if (pn == 19) { mode = 1; gidx = 24; mixer = 2; }
        else               { mode = 2; mixer = 2; }
        const float* gain = gidx >= 0 ? in[gidx] : nullptr;
        const int region = pm < 256 ? 0 : (pm < 260 ? 1 : 2);
        float gv[2][8];
#pragma unroll
        for (int bj = 0; bj < 2; ++bj)
#pragma unroll
            for (int i = 0; i < 8; ++i) gv[bj][i] = gain ? gain[32 * bj + 8 * fq + i] : 1.0f;
        size_t koffb = 0; int kpitch = 256, spb = 0, soff = 0, nh = 4, vp = 256, keep = 0; size_t obase = 0; int opitch = 256;
        if (mode != 0) {
            if (mixer == 0) { opitch = 128; kpitch = 128; nh = 2; keep = 128;
                if (region == 0) { koffb = mode == 1 ? WS_KAP : WS_VTAP; vp = 4096; obase = mode == 1 ? OFF_AKP : OFF_AVP; }
                else             { koffb = mode == 1 ? WS_KAS : WS_VTAS; vp = 192; spb = 192; soff = 128; obase = mode == 1 ? OFF_AKS : OFF_AVS; } }
            else if (mixer == 1) { keep = 512;
                if (region == 0) { koffb = mode == 1 ? WS_KBP : WS_VTBP; vp = 4096; obase = mode == 1 ? OFF_BKP : OFF_BVP; }
                else             { koffb = mode == 1 ? WS_KBS : WS_VTBS; vp = 576; spb = 576; soff = 512; obase = mode == 1 ? OFF_BKS : OFF_BVS; } }
            else { koffb = mode == 1 ? WS_MKP : WS_MVTP; vp = 256; obase = mode == 1 ? OFF_MKP : OFF_MVP; }
        }
        bf16* kbase = (bf16*)(ws + koffb);
#pragma unroll
        for (int ai = 0; ai < 2; ++ai)
#pragma unroll
            for (int m = 0; m < 4; ++m) {
                const int row = row0 + ai * 128 + m * 16; const float rs = rsv[ai][m];
                f32x2 v2[2][4];
#pragma unroll
                for (int bj = 0; bj < 2; ++bj)
#pragma unroll
                    for (int k = 0; k < 4; ++k) v2[bj][k] = (f32x2){acc[ai][bj][m][k >> 1][(k & 1) * 2], acc[ai][bj][m][k >> 1][(k & 1) * 2 + 1]} * rs;
                if (gain) {
                    f32x2 ss2 = (f32x2){0.f, 0.f};
#pragma unroll
                    for (int bj = 0; bj < 2; ++bj)
#pragma unroll
                        for (int k = 0; k < 4; ++k) ss2 += v2[bj][k] * v2[bj][k];
                    const float ss = fq_sum(ss2.x + ss2.y);
                    const float hs = rsqrtf(ss * (1.0f / 64.0f) + EPS) * (mode == 0 ? C2 : 1.0f);
#pragma unroll
                    for (int bj = 0; bj < 2; ++bj)
#pragma unroll
                        for (int k = 0; k < 4; ++k) v2[bj][k] *= (f32x2){gv[bj][2 * k], gv[bj][2 * k + 1]} * hs;
                }
                if (rope_on) {
                    const float posf = (float)(region == 0 ? (row & 4095) : 1024 + (row & 63));
#pragma unroll
                    for (int k = 0; k < 4; ++k) {
                        const f32x2 ir2 = (f32x2){__builtin_amdgcn_exp2f(-(float)(8 * fq + 2 * k) * 0.41524101186f), __builtin_amdgcn_exp2f(-(float)(8 * fq + 2 * k + 1) * 0.41524101186f)} * 0.15915494309f;
                        const f32x2 rv = ir2 * posf;
                        const float r0 = __builtin_amdgcn_fractf(rv.x), r1 = __builtin_amdgcn_fractf(rv.y);
                        const f32x2 c2 = (f32x2){__builtin_amdgcn_cosf(r0), __builtin_amdgcn_cosf(r1)}, s2 = (f32x2){__builtin_amdgcn_sinf(r0), __builtin_amdgcn_sinf(r1)};
                        const f32x2 lo2 = v2[0][k], hi2 = v2[1][k]; v2[0][k] = lo2 * c2 - hi2 * s2; v2[1][k] = lo2 * s2 + hi2 * c2; }
                }
                float v[2][8];
#pragma unroll
                for (int bj = 0; bj < 2; ++bj)
#pragma unroll
                    for (int k = 0; k < 4; ++k) { v[bj][2 * k] = v2[bj][k].x; v[bj][2 * k + 1] = v2[bj][k].y; }
                if (mode == 0) {
#pragma unroll
                    for (int bj = 0; bj < 2; ++bj) { u32x4 w; w.x = cvt_pk_bf16(v[bj][0], v[bj][1]); w.y = cvt_pk_bf16(v[bj][2], v[bj][3]);
                        w.z = cvt_pk_bf16(v[bj][4], v[bj][5]); w.w = cvt_pk_bf16(v[bj][6], v[bj][7]);
                        *(u32x4*)(Q + (size_t)row * D + qcol + 32 * bj + 8 * fq) = w; }
                } else {
                    int vb, tpos, orow;
                    if (region == 0) { const int pos = row & 4095, b = row >> 12; vb = b; tpos = pos; orow = pos >= 4096 - keep ? b * keep + pos - (4096 - keep) : -1; }
                    else if (region == 1) { const int sb = (row - MP) >> 6, t = row & 63; vb = sb; tpos = soff + t; orow = row - MP; }
                    else { vb = (row - M) >> 8; tpos = row & 255; orow = row - M; }
                    bf16* strm = kbase + (size_t)(vb * nh + hh) * vp * 64;
                    if (mode == 1) {
#pragma unroll
                        for (int bj = 0; bj < 2; ++bj) { u32x4 w; w.x = cvt_pk_bf16(v[bj][0], v[bj][1]); w.y = cvt_pk_bf16(v[bj][2], v[bj][3]);
                            w.z = cvt_pk_bf16(v[bj][4], v[bj][5]); w.w = cvt_pk_bf16(v[bj][6], v[bj][7]);
                            *(u32x4*)(strm + kf_off(tpos, 32 * bj + 8 * fq)) = w; }
                    } else {
#pragma unroll
                        for (int bj = 0; bj < 2; ++bj) { bf16* vt = strm + vf_off(tpos, 32 * bj + 8 * fq);
#pragma unroll
                            for (int i = 0; i < 8; i += 2) { const unsigned w = cvt_pk_bf16(v[bj][i], v[bj][i + 1]);
                                vt[i * 8] = (bf16)(w & 0xffffu); vt[(i + 1) * 8] = (bf16)(w >> 16); } }
                    }
                    if (orow >= 0) { float* op = out + obase + (size_t)orow * opitch + hh * 64 + 8 * fq;
#pragma unroll
                        for (int bj = 0; bj < 2; ++bj) { *(f32x4*)(op + 32 * bj) = (f32x4){v[bj][0], v[bj][1], v[bj][2], v[bj][3]}; *(f32x4*)(op + 32 * bj + 4) = (f32x4){v[bj][4], v[bj][5], v[bj][6], v[bj][7]}; }
                    }
                }
            }
    }
};
struct EpiBr {
    static constexpr bool PERM = true, AFTER_DRAIN = false, HOOK = true, RSLDS = false;
    typedef NoRs RsT;
    unsigned char* ws;
    __device__ __forceinline__ void hook(f32x4 (&acc)[2][2][4][2], const Unit& u, int t, int wr, int wc, int fr, int fq) const {
        const int num = (t == 8) ? 0 : 1;
        int tidg = (wr * 4 + wc) * 64 + fq * 16 + fr;
        asm volatile("" : "+v"(tidg));
        const unsigned char* G = ws + WS_H;
        u32x2 a[2][4][2], b[2][4][2];
#pragma unroll
        for (int ai = 0; ai < 2; ++ai)
#pragma unroll
            for (int m = 0; m < 4; ++m)
#pragma unroll
                for (int bj = 0; bj < 2; ++bj) { a[ai][m][bj] = *(const u32x2*)(G + gate_off8(u.pm, num * 4 + u.pn, ai, m, bj, tidg)); b[ai][m][bj] = *(const u32x2*)(G + gate_off8(u.pm, num * 4 + 4 + u.pn, ai, m, bj, tidg)); }
#pragma unroll
        for (int ai = 0; ai < 2; ++ai)
#pragma unroll
            for (int m = 0; m < 4; ++m)
#pragma unroll
                for (int bj = 0; bj < 2; ++bj)
#pragma unroll
                    for (int i = 0; i < 8; i += 2) { const unsigned wa = i < 4 ? a[ai][m][bj].x : a[ai][m][bj].y, wb = i < 4 ? b[ai][m][bj].x : b[ai][m][bj].y;
                        const f32x2 rb = (f32x2){__builtin_amdgcn_rcpf(ub(wb, i & 3)), __builtin_amdgcn_rcpf(ub(wb, (i + 1) & 3))};
                        const f32x2 r2 = (f32x2){ub(wa, i & 3), ub(wa, (i + 1) & 3)} * rb;
                        const f32x2 v2 = (f32x2){acc[ai][bj][m][i >> 2][i & 3], acc[ai][bj][m][i >> 2][(i & 3) + 1]} * r2;
                        acc[ai][bj][m][i >> 2][i & 3] = v2.x; acc[ai][bj][m][i >> 2][(i & 3) + 1] = v2.y; }
    }
    __device__ __forceinline__ void operator()(const f32x4 (&acc)[2][2][4][2], const Unit& u, int wr, int wc, int fr, int fq) const {
        const unsigned char* G = ws + WS_H; bf16* outp = (bf16*)(ws + WS_Q);
        const int row0 = u.pm * 256 + wr * 64 + fr, col0 = u.pn * 256 + wc * 32 + 8 * fq, tidg = (wr * 4 + wc) * 64 + fq * 16 + fr;
        u32x2 a[2][4][2];
#pragma unroll
        for (int ai = 0; ai < 2; ++ai)
#pragma unroll
            for (int m = 0; m < 4; ++m)
#pragma unroll
                for (int bj = 0; bj < 2; ++bj) a[ai][m][bj] = *(const u32x2*)(G + gate_off8(u.pm, 8 + u.pn, ai, m, bj, tidg));
#pragma unroll
        for (int ai = 0; ai < 2; ++ai)
#pragma unroll
            for (int m = 0; m < 4; ++m) {
                const int row = row0 + ai * 128 + m * 16;
#pragma unroll
                for (int bj = 0; bj < 2; ++bj) { u32x4 w;
#pragma unroll
                    for (int j = 0; j < 4; ++j) { const unsigned wa = j < 2 ? a[ai][m][bj].x : a[ai][m][bj].y;
                        const f32x2 g2 = (f32x2){ub(wa, (2 * j) & 3), ub(wa, (2 * j + 1) & 3)} * (1.0f / 255.0f);
                        const f32x2 v2 = (f32x2){acc[ai][bj][m][j >> 1][(j & 1) * 2], acc[ai][bj][m][j >> 1][(j & 1) * 2 + 1]} * g2;
                        w[j] = cvt_pk_bf16(v2.x, v2.y); }
                    *(u32x4*)(outp + (size_t)row * D + col0 + bj * 128) = w; }
            }
    }
};
constexpr int NSLICE = 11, SLICE_NT = 4;
struct OrderSlice {
    int G, c;
    __device__ bool next(int i, Unit& u) const { const int L = i * G + c; if (L >= 16 * NSLICE) return false; const int tile = L & 15; u.ks = L >> 4; u.pm = 256 + (tile >> 2); u.pn = tile & 3; return true; }
    __device__ __forceinline__ void a_ready(const Unit&) const {}
    __device__ __forceinline__ void done(const Unit&) const {}
};
struct EpiPart {
    static constexpr bool PERM = true, AFTER_DRAIN = false, HOOK = false, RSLDS = false;
    typedef NoRs RsT;
    unsigned char* ws;
    __device__ __forceinline__ void operator()(const f32x4 (&acc)[2][2][4][2], const Unit& u, int wr, int wc, int fr, int fq) const {
        float* P = (float*)(ws + WS_PART) + (size_t)u.ks * (1024 * 1024);
        const int row0 = (u.pm - 256) * 256 + wr * 64 + fr, col0 = u.pn * 256 + wc * 32 + 8 * fq;
#pragma unroll
        for (int ai = 0; ai < 2; ++ai)
#pragma unroll
            for (int m = 0; m < 4; ++m)
#pragma unroll
                for (int bj = 0; bj < 2; ++bj) { float* p = P + (size_t)(row0 + ai * 128 + m * 16) * 1024 + col0 + bj * 128; *(f32x4*)p = acc[ai][bj][m][0]; *(f32x4*)(p + 4) = acc[ai][bj][m][1]; }
    }
};
__device__ __forceinline__ float sample_row_sum(const unsigned char* ws, int r, int lane, f32x4 (&xn)[4]) {
    const u32x2* xb = (const u32x2*)((const bf16*)(ws + WS_XB) + (size_t)(MP + r) * D); const float* P = (const float*)(ws + WS_PART) + (size_t)r * 1024;
    float ss = 0.f;
#pragma unroll
    for (int j = 0; j < 4; ++j) {
        const u32x2 o = xb[lane + 64 * j]; f32x4 p[NSLICE];
#pragma unroll
        for (int s_ = 0; s_ < NSLICE; ++s_) p[s_] = ((const f32x4*)(P + (size_t)s_ * (1024 * 1024)))[lane + 64 * j];
        f32x4 a = p[0];
#pragma unroll
        for (int s_ = 1; s_ < NSLICE; ++s_) a += p[s_];
        xn[j] = (f32x4){bf_lo(o.x), bf_hi(o.x), bf_lo(o.y), bf_hi(o.y)} + a * 0.5f;
        ss += (xn[j][0] * xn[j][0] + xn[j][1] * xn[j][1]) + (xn[j][2] * xn[j][2] + xn[j][3] * xn[j][3]);
    }
#pragma unroll
    for (int o_ = 1; o_ < 64; o_ <<= 1) ss += __shfl_xor(ss, o_);
    return ss;
}
struct OrderIn {
    pg8::StaticOrder base; int G, c;
    __device__ void init(int G_, int c_) { base.init(M, N_IN, G_, c_); G = G_; c = c_; }
    __device__ bool next(int i, Unit& u) const {
        const long L = (long)i * G + c; if (L < base.nwg) return base.next(i, u);
        const int r = (int)(L - base.nwg); if (r >= 32) return false;
        u.pm = 260 + (r >> 1); u.pn = 19 + (r & 1); u.ks = 0; return true;
    }
    __device__ __forceinline__ void a_ready(const Unit&) const {}
    __device__ __forceinline__ void done(const Unit&) const {}
};

__device__ __forceinline__ float max3f(float a, float b, float c) { float r; asm("v_max3_f32 %0, %1, %2, %3" : "=v"(r) : "v"(a), "v"(b), "v"(c)); return r; }
__device__ __forceinline__ int crow(int r, int hi) { return (r & 3) + 8 * (r >> 2) + 4 * hi; }
__device__ __forceinline__ void attn_task(const bf16* Qp, const bf16* Kp, const bf16* Vtp, int ntiles, bool has_sink, float sink2,
                                          bool has_bias, const LAS float* biasl, int j0, int qin, bf16* Yp, int lane) {
    const int r32 = lane & 31, hi = lane >> 5;
    bf16x8 qr[4];
#pragma unroll
    for (int d0 = 0; d0 < 4; ++d0) qr[d0] = *(const bf16x8*)(Qp + (size_t)r32 * D + d0 * 16 + hi * 8);
    f32x16 o0 = {}, o1 = {};
    float mrun = 0.f, lsum = 0.f;
    const bf16* kp = Kp + lane * 8;
    const bf16* vp = Vtp + lane * 8;
    bf16x8 kf[2][4], vf[2][4], kn[2][4], vn[2][4];
#define ATT_LOAD(KF, VF, IT) do { \
    _Pragma("unroll") for (int blk = 0; blk < 2; ++blk) _Pragma("unroll") for (int d0 = 0; d0 < 4; ++d0) KF[blk][d0] = *(const bf16x8*)(kp + ((2 * (IT) + blk) * 4 + d0) * 512); \
    _Pragma("unroll") for (int d0 = 0; d0 < 2; ++d0) _Pragma("unroll") for (int ks = 0; ks < 4; ++ks) VF[d0][ks] = *(const bf16x8*)(vp + ((2 * (IT) + d0) * 4 + ks) * 512); } while (0)
    ATT_LOAD(kf, vf, 0);
    for (int it = 0; it < ntiles; ++it) {
        if (it + 1 < ntiles) ATT_LOAD(kn, vn, it + 1);
        f32x16 p0 = {}, p1 = {};
        __builtin_amdgcn_s_setprio(1);
#pragma unroll
        for (int d0 = 0; d0 < 4; ++d0) { p0 = __builtin_amdgcn_mfma_f32_32x32x16_bf16(kf[0][d0], qr[d0], p0, 0, 0, 0); p1 = __builtin_amdgcn_mfma_f32_32x32x16_bf16(kf[1][d0], qr[d0], p1, 0, 0, 0); }
        __builtin_amdgcn_s_setprio(0);
        if (has_bias) {
            const int j = j0 - it;
            if (j >= 3) { const float bc = biasl[256];
#pragma unroll
                for (int r = 0; r < 16; ++r) { p0[r] += bc; p1[r] += bc; } }
            else { const int base = 64 * j + qin + r32 + 128 - 4 * hi;
#pragma unroll
                for (int r = 0; r < 16; ++r) { const int kvl = (r & 3) + 8 * (r >> 2); int i0 = base - kvl, i1 = base - kvl - 32; i0 = i0 > 256 ? 256 : i0; i1 = i1 > 256 ? 256 : i1;
                    p0[r] += biasl[i0]; p1[r] += biasl[i1]; } }
        }
        float mx;
        { float ma = max3f(p0[0], p0[1], p1[0]), mb = max3f(p0[2], p0[3], p1[1]); ma = max3f(ma, p1[2], p1[3]);
#pragma unroll
          for (int r = 4; r < 16; r += 4) { ma = max3f(ma, p0[r], p0[r + 1]); mb = max3f(mb, p0[r + 2], p0[r + 3]); ma = max3f(ma, p1[r], p1[r + 1]); mb = max3f(mb, p1[r + 2], p1[r + 3]); }
          mx = fmaxf(ma, mb); }
        { const auto rr = __builtin_amdgcn_permlane32_swap(__float_as_uint(mx), __float_as_uint(mx), false, false);
          mx = fmaxf(__uint_as_float(rr[0]), __uint_as_float(rr[1])) - mrun; }
        if (it == 0 || __any(mx > 8.0f)) {
            const float delta = it == 0 ? mx : fmaxf(mx, 0.f), alpha = __builtin_amdgcn_exp2f(-delta);
            mrun += delta; lsum *= alpha;
#pragma unroll
            for (int r = 0; r < 16; ++r) { o0[r] *= alpha; o1[r] *= alpha; }
        }
        f32x2 ps2 = (f32x2){0.f, 0.f};
#pragma unroll
        for (int r = 0; r < 16; r += 2) {
            const f32x2 a0 = (f32x2){p0[r], p0[r + 1]} - mrun, a1 = (f32x2){p1[r], p1[r + 1]} - mrun;
            p0[r] = __builtin_amdgcn_exp2f(a0.x); p0[r + 1] = __builtin_amdgcn_exp2f(a0.y); p1[r] = __builtin_amdgcn_exp2f(a1.x); p1[r + 1] = __builtin_amdgcn_exp2f(a1.y);
            ps2 += (f32x2){p0[r], p0[r + 1]} + (f32x2){p1[r], p1[r + 1]};
        }
        lsum += ps2.x + ps2.y;
        bf16x8 pk[4];
#pragma unroll
        for (int ks = 0; ks < 4; ++ks) { u32x4 w;
#pragma unroll
            for (int j = 0; j < 4; ++j) { const int r = 8 * (ks & 1) + 2 * j; w[j] = (ks < 2) ? cvt_pk_bf16(p0[r], p0[r + 1]) : cvt_pk_bf16(p1[r], p1[r + 1]); }
            pk[ks] = __builtin_bit_cast(bf16x8, w); }
        __builtin_amdgcn_s_setprio(1);
#pragma unroll
        for (int ks = 0; ks < 4; ++ks) { o0 = __builtin_amdgcn_mfma_f32_32x32x16_bf16(vf[0][ks], pk[ks], o0, 0, 0, 0); o1 = __builtin_amdgcn_mfma_f32_32x32x16_bf16(vf[1][ks], pk[ks], o1, 0, 0, 0); }
        __builtin_amdgcn_s_setprio(0);
#pragma unroll
        for (int a = 0; a < 2; ++a)
#pragma unroll
            for (int b = 0; b < 4; ++b) { kf[a][b] = kn[a][b]; vf[a][b] = vn[a][b]; }
    }
#undef ATT_LOAD
    float l; { const auto rr = __builtin_amdgcn_permlane32_swap(__float_as_uint(lsum), __float_as_uint(lsum), false, false); l = __uint_as_float(rr[0]) + __uint_as_float(rr[1]); }
    if (has_sink) l += __builtin_amdgcn_exp2f(sink2 - mrun);
    const float inv = 1.0f / l;
    bf16* yp = Yp + (size_t)r32 * D + 4 * hi;
#pragma unroll
    for (int rg = 0; rg < 4; ++rg) {
        u32x2 w0, w1; w0.x = cvt_pk_bf16(o0[4 * rg] * inv, o0[4 * rg + 1] * inv); w0.y = cvt_pk_bf16(o0[4 * rg + 2] * inv, o0[4 * rg + 3] * inv);
        w1.x = cvt_pk_bf16(o1[4 * rg] * inv, o1[4 * rg + 1] * inv); w1.y = cvt_pk_bf16(o1[4 * rg + 2] * inv, o1[4 * rg + 3] * inv);
        *(u32x2*)(yp + 8 * rg) = w0; *(u32x2*)(yp + 32 + 8 * rg) = w1;
    }
}

#define XB_TMO      128
#define XB_XCNT(j)  (256  + 64 * (j))
#define XB_XSUB(j)  (1280 + 64 * (j))
#define XB_XGEN(j)  (2304 + 64 * (j))
#define XB_TOP      3328
#define XB_TOPGEN   3392
#define XCD_BAR_WORDS 3456
#define XB_SPIN_CAP (1u << 18)

__device__ __forceinline__ unsigned xb_ld(unsigned* p)              { return __hip_atomic_load(p, __ATOMIC_RELAXED, __HIP_MEMORY_SCOPE_AGENT); }
__device__ __forceinline__ unsigned xb_add(unsigned* p, unsigned v) { return __hip_atomic_fetch_add(p, v, __ATOMIC_RELAXED, __HIP_MEMORY_SCOPE_AGENT); }
__device__ __forceinline__ unsigned xb_xcc_id() { return (unsigned)__builtin_amdgcn_s_getreg((3 << 11) | 20) & 0xFu; }
#define XB_SPIN(cond, bar) do { unsigned _sp = 0; while (cond) { __builtin_amdgcn_s_sleep(1); \
    if ((++_sp & 255u) == 0u) { if (xb_ld(&(bar)[XB_TMO])) break; if (_sp > XB_SPIN_CAP) { atomicAdd(&(bar)[XB_TMO], 1u); break; } } } } while (0)

struct XcdBarrier {
    unsigned* bar; unsigned x; int w0;
    volatile LAS unsigned* st;
};

__device__ __forceinline__ XcdBarrier xcd_barrier_post(unsigned* bar, volatile LAS unsigned* st) {
    XcdBarrier b; b.bar = bar; b.x = xb_xcc_id(); b.st = st;
    if (threadIdx.x == 0) (void)xb_add(&bar[XB_XCNT(b.x)], 1u);
    return b;
}
__device__ __forceinline__ void xcd_barrier_complete(unsigned* bar, unsigned x, unsigned& nloc, unsigned& nx) {
    const unsigned G = gridDim.x * gridDim.y * gridDim.z;
    unsigned sum, cnt, mine, sp = 0u;
    for (;;) {
        sum = 0u; cnt = 0u; mine = 0u;
#pragma unroll
        for (unsigned j = 0; j < 16; ++j) { const unsigned c = xb_ld(&bar[XB_XCNT(j)]); sum += c; cnt += (c > 0u) ? 1u : 0u; mine = (j == x) ? c : mine; }
        if (sum == G) break;
        __builtin_amdgcn_s_sleep(1);
        if ((++sp & 255u) == 0u) { if (xb_ld(&bar[XB_TMO])) break; if (sp > XB_SPIN_CAP) { atomicAdd(&bar[XB_TMO], 1u); break; } }
    }
    nloc = mine > 0u ? mine : 1u; nx = cnt > 0u ? cnt : 1u;
}

__device__ __forceinline__ void xcd_barrier(const XcdBarrier& b) {
    asm volatile("s_waitcnt vmcnt(0)" ::: "memory");
    __syncthreads();
    if (b.w0 && lane_id() == 0) {
        unsigned* bar = b.bar;
        __builtin_amdgcn_s_waitcnt(0);
        unsigned nloc = b.st[0], nx = b.st[1];
        if (nloc == 0u) { xcd_barrier_complete(bar, b.x, nloc, nx); b.st[0] = nloc; b.st[1] = nx; }
        const unsigned old = xb_add(&bar[XB_XSUB(b.x)], 1u);
        const unsigned gen = old / nloc;
        if (old + 1u == (gen + 1u) * nloc) {
            __builtin_amdgcn_fence(__ATOMIC_RELEASE, "agent");
            asm volatile("s_waitcnt vmcnt(0)" ::: "memory");
            const unsigned og = xb_add(&bar[XB_TOP], 1u);
            const unsigned tg = og / nx;
            if (og + 1u == (tg + 1u) * nx) xb_add(&bar[XB_TOPGEN], 1u);
            else XB_SPIN(xb_ld(&bar[XB_TOPGEN]) == tg, bar);
            __builtin_amdgcn_fence(__ATOMIC_ACQUIRE, "agent");
            xb_add(&bar[XB_XGEN(b.x)], 1u);
            asm volatile("s_waitcnt vmcnt(0)" ::: "memory");
        } else {
            XB_SPIN(xb_ld(&bar[XB_XGEN(b.x)]) == gen, bar);
            __builtin_amdgcn_fence(__ATOMIC_ACQUIRE, "agent");
            asm volatile("s_waitcnt vmcnt(0)" ::: "memory");
        }
    }
    __syncthreads();
}

struct Args { const float* in[36]; float* out; unsigned char* ws; int ph_lo, ph_hi; };

__device__ __forceinline__ float wave_sum(float v) {
#pragma unroll
    for (int o = 1; o < 64; o <<= 1) v += __shfl_xor(v, o);
    return v;
}
__device__ __forceinline__ void tr_item(const float* W, int K, int N, const float* gain, bf16* WT, int pitch, int koff, int mapkind, int rowoff, LAS float* scr, int item, int lane) {
    const int nblk = N / 32, kb = item / nblk, nb = item % nblk, k0 = 64 * kb, n0 = 32 * nb;
#pragma unroll 8
    for (int i = 0; i < 32; ++i) { const int kk = 2 * i + (lane >> 5); float w = W[(size_t)(k0 + kk) * N + n0 + (lane & 31)]; if (gain) w *= gain[k0 + kk]; scr[kk * 33 + (lane & 31)] = w; }
    asm volatile("s_waitcnt lgkmcnt(0)" ::: "memory");
    int drow0;
    if (mapkind == 0) drow0 = n0;
    else if (mapkind == 1) drow0 = 256 * (n0 / 128) + (n0 % 128);
    else if (mapkind == 2) drow0 = 256 * (n0 / 128) + 128 + (n0 % 128);
    else { const int tile = n0 / 256, hh = (n0 % 256) / 64, dd = n0 % 64; drow0 = 256 * tile + 128 * (dd / 32) + 32 * hh; }
    drow0 += rowoff;
    const int c = lane & 7;
#pragma unroll
    for (int j = 0; j < 4; ++j) { const int n = (lane >> 3) + 8 * j; const LAS float* s = scr + (8 * c) * 33 + n;
        u32x4 o; o.x = cvt_pk_bf16(s[0 * 33], s[1 * 33]); o.y = cvt_pk_bf16(s[2 * 33], s[3 * 33]); o.z = cvt_pk_bf16(s[4 * 33], s[5 * 33]); o.w = cvt_pk_bf16(s[6 * 33], s[7 * 33]);
        *(u32x4*)(WT + (size_t)(drow0 + n) * pitch + koff + k0 + 8 * c) = o; }
    asm volatile("s_waitcnt lgkmcnt(0)" ::: "memory");
}
__device__ const double INVF[32] = {1.0, 0.7498942093324559, 0.5623413251903491, 0.4216965034285822, 0.31622776601683794, 0.23713737056616552, 0.1778279410038923, 0.1333521432163324,
    0.1, 0.07498942093324558, 0.05623413251903491, 0.042169650342858224, 0.03162277660168379, 0.023713737056616554, 0.01778279410038923, 0.01333521432163324,
    0.01, 0.007498942093324558, 0.005623413251903491, 0.004216965034285823, 0.0031622776601683794, 0.0023713737056616554, 0.0017782794100389228, 0.001333521432163324,
    0.001, 0.0007498942093324559, 0.0005623413251903491, 0.00042169650342858224, 0.00031622776601683794, 0.00023713737056616554, 0.00017782794100389227, 0.0001333521432163324};

__global__ void __launch_bounds__(NTHREADS, 2) mega(Args args) {
    extern __shared__ __attribute__((aligned(16))) unsigned char lds_raw[];
    LAS unsigned char* lds = (LAS unsigned char*)lds_raw;
    const int wave_s = __builtin_amdgcn_readfirstlane((int)threadIdx.x >> 6);
#define TIDS() int tid = wave_s * 64 + lane_id(); const int lane = tid & 63, wave = wave_s; (void)lane; (void)wave
    const int G = gridDim.x;
    int bx = blockIdx.x;
    int vcu = (G % 8 == 0) ? (bx % 8) * (G / 8) + bx / 8 : bx;
    float* out = args.out;
#define WSP(name) unsigned char* name = args.ws; asm volatile("" : "+s"(name))
#define PTR(T, base, off) ((T*)((base) + (off)))
    const float* const* in = args.in;
    const int lo = args.ph_lo, hi = args.ph_hi;
#define IN(k) (lo <= (k) && (k) < hi)
#if MK_MULTI
#define GRID_SYNC() do { } while (0)
#else
    cg::grid_group grid = cg::this_grid();
    volatile LAS unsigned* MISC = (volatile LAS unsigned*)(lds + RING_BYTES + 512);
    if (threadIdx.x == 0) { MISC[0] = 0u; MISC[1] = 0u; }
    __syncthreads();
    XcdBarrier xbar; xbar.bar = (unsigned*)args.ws; xbar.x = xb_xcc_id(); xbar.st = MISC; xbar.w0 = (wave_s == 0);
    if (threadIdx.x == 0) MISC[2] = xb_add(&xbar.bar[XB_XCNT(xbar.x)], 1u);
    __syncthreads();
#define GRID_SYNC() xcd_barrier(xbar)
#endif

#if PROBE_DUP == 10
    for (int rep0_ = 0; rep0_ < 2; ++rep0_)
#endif
    if (IN(0) && !SKIP_P0) {
        TIDS();
        WSP(w0);
        bf16 *WUP1 = PTR(bf16, w0, WS_WUP1), *WDN1 = PTR(bf16, w0, WS_WDN1), *WUP2 = PTR(bf16, w0, WS_WUP2), *WDN2 = PTR(bf16, w0, WS_WDN2), *WIN = PTR(bf16, w0, WS_WIN),
             *WBR = PTR(bf16, w0, WS_WBR), *WOUT = PTR(bf16, w0, WS_WOUT), *KAS = PTR(bf16, w0, WS_KAS), *VTAS = PTR(bf16, w0, WS_VTAS), *KBS = PTR(bf16, w0, WS_KBS),
             *VTBS = PTR(bf16, w0, WS_VTBS), *MKS = PTR(bf16, w0, WS_MKS), *MVTS = PTR(bf16, w0, WS_MVTS), *XB = PTR(bf16, w0, WS_XB);
        float* SSQ = PTR(float, w0, WS_SSQ); f32x2* ROPE = PTR(f32x2, w0, WS_ROPE);
        LAS float* scr = (LAS float*)(lds + wave * 16384);
        const int gw = vcu * NWAVES + wave, NGW = G * NWAVES;
        constexpr int I_UPH = 16 * 88, I_DN = 44 * 32, I_IN = 16 * 56, I_GT = 16 * 96, I_MEM = 16 * 16, I_BRA = 8 * 32, I_BRB = 4 * 32, I_OUT = 16 * 32;
        constexpr int NITEMS = 4 * I_UPH + 2 * I_DN + I_IN + I_GT + I_MEM + I_BRA + 2 * I_BRB + I_OUT;
        for (int it = gw; it < NITEMS; it += NGW) {
            int r = it;
            if (r < I_UPH) { tr_item(in[10], D, FF, in[9], WUP1, D, 0, 1, 0, scr, r, lane); continue; } r -= I_UPH;
            if (r < I_UPH) { tr_item(in[11], D, FF, in[9], WUP1, D, 0, 2, 0, scr, r, lane); continue; } r -= I_UPH;
            if (r < I_DN)  { tr_item(in[12], FF, D, nullptr, WDN1, FF, 0, 0, 0, scr, r, lane); continue; } r -= I_DN;
            if (r < I_UPH) { tr_item(in[32], D, FF, in[31], WUP2, D, 0, 1, 0, scr, r, lane); continue; } r -= I_UPH;
            if (r < I_UPH) { tr_item(in[33], D, FF, in[31], WUP2, D, 0, 2, 0, scr, r, lane); continue; } r -= I_UPH;
            if (r < I_DN)  { tr_item(in[34], FF, D, nullptr, WDN2, FF, 0, 0, 0, scr, r, lane); continue; } r -= I_DN;
            if (r < I_IN)  { tr_item(in[14], D, 1792, in[13], WIN, D, 0, 3, 0, scr, r, lane); continue; } r -= I_IN;
            if (r < I_GT)  { tr_item(in[25], D, 3072, in[13], WIN, D, 0, 0, 1792, scr, r, lane); continue; } r -= I_GT;
            if (r < I_MEM) { tr_item(in[23], D, 512, in[22], WIN, D, 0, 3, N_IN, scr, r, lane); continue; } r -= I_MEM;
            if (r < I_BRA) { tr_item(in[27], 512, D, nullptr, WBR, D, 0, 0, 0, scr, r, lane); continue; } r -= I_BRA;
            if (r < I_BRB) { tr_item(in[28], 256, D, nullptr, WBR, D, 512, 0, 0, scr, r, lane); continue; } r -= I_BRB;
            if (r < I_BRB) { tr_item(in[29], 256, D, nullptr, WBR, D, 768, 0, 0, scr, r, lane); continue; } r -= I_BRB;
            tr_item(in[30], D, D, nullptr, WOUT, D, 0, 0, 0, scr, r, lane);
        }
        for (int r = gw; r < MA; r += NGW) {
            const float* src = r < MP ? in[0] + (size_t)r * D : (r < M ? in[1] + (size_t)(r - MP) * D : in[8] + (size_t)(r - M) * D);
            f32x4 v[4]; float ss = 0.f;
#pragma unroll
            for (int j = 0; j < 4; ++j) { v[j] = ((const f32x4*)src)[lane + 64 * j]; ss += (v[j][0] * v[j][0] + v[j][1] * v[j][1]) + (v[j][2] * v[j][2] + v[j][3] * v[j][3]); }
            ss = wave_sum(ss);
            u32x2* o8 = (u32x2*)(XB + (size_t)r * D);
#pragma unroll
            for (int j = 0; j < 4; ++j) { u32x2 w; w.x = cvt_pk_bf16(v[j][0], v[j][1]); w.y = cvt_pk_bf16(v[j][2], v[j][3]); o8[lane + 64 * j] = w; }
            if (lane < 16) SSQ[(size_t)r * 16 + lane] = lane == 0 ? ss : 0.f;
        }
        const int gt = vcu * NTHREADS + tid, NTH = G * NTHREADS;
        for (int i = gt; i < 16 * 128 * 128; i += NTH) { const int sb = i >> 14, t = (i >> 7) & 127, c = i & 127;
            const size_t so = (size_t)(sb * 2 + (c >> 6)) * 192 * 64;
            KAS[so + kf_off(t, c & 63)] = (bf16)(cvt_pk_bf16(in[2][i], 0.f) & 0xffffu);
            VTAS[so + vf_off(t, c & 63)] = (bf16)(cvt_pk_bf16(in[3][i], 0.f) & 0xffffu); }
        for (int i = gt; i < 16 * 512 * 256; i += NTH) { const int sb = i >> 17, t = (i >> 8) & 511, c = i & 255;
            const size_t so = (size_t)(sb * 4 + (c >> 6)) * 576 * 64;
            KBS[so + kf_off(t, c & 63)] = (bf16)(cvt_pk_bf16(in[4][i], 0.f) & 0xffffu);
            VTBS[so + vf_off(t, c & 63)] = (bf16)(cvt_pk_bf16(in[5][i], 0.f) & 0xffffu); }
        for (int i = gt; i < 16 * 256 * 256; i += NTH) { const int sb = i >> 16, t = (i >> 8) & 255, c = i & 255;
            const size_t so = (size_t)(sb * 4 + (c >> 6)) * 256 * 64;
            MKS[so + kf_off(t, c & 63)] = (bf16)(cvt_pk_bf16(in[6][i], 0.f) & 0xffffu);
            MVTS[so + vf_off(t, c & 63)] = (bf16)(cvt_pk_bf16(in[7][i], 0.f) & 0xffffu); }
    }
#if MK_MULTI
    if (IN(0) && IN(1)) GRID_SYNC();
#else
    if (IN(0) && IN(1)) grid.sync();
    {
        unsigned* ctl = (unsigned*)args.ws; bool even = (G % 8 == 0);
        for (int j = 0; j < 8; ++j) even = even && (xb_ld(&ctl[XB_XCNT(j)]) == (unsigned)(G / 8));
        const int rk = (int)MISC[2], xc = (int)xbar.x;
        if (even && xc < 8 && rk < G / 8) { bx = rk * 8 + xc; vcu = xc * (G / 8) + rk; }
    }
#endif

#pragma unroll 1
    for (int pass = 0; pass < 2; ++pass) {
        const int ph = pass == 0 ? 1 : 7;
        if (IN(ph) && !SKIP_UP) {
            WSP(w1);
            pg8::Gemm g{PTR(bf16, w1, WS_XB), pass == 0 ? PTR(bf16, w1, WS_WUP1) : PTR(bf16, w1, WS_WUP2), M, N_UP, D, D / 64}; pg8::StaticOrder S; S.init(M, N_UP, G, bx);
            EpiUp E{w1};
            __syncthreads();
            pg8::gemm_phase<EpiUp, pg8::StaticOrder, PG8_ALIGN, PG8_SP2>(lds, g, S, E, wave_s);
#if PROBE_DUP == 1
            if (pass == 0) { __syncthreads(); pg8::gemm_phase<EpiUp, pg8::StaticOrder, PG8_ALIGN, PG8_SP2>(lds, g, S, E, wave_s); }
#endif
        }
        if (IN(ph) && IN(ph + 1)) GRID_SYNC();
        if (IN(ph + 1) && !SKIP_DN) {
            WSP(w2);
            pg8::Gemm g{PTR(bf16, w2, WS_H), pass == 0 ? PTR(bf16, w2, WS_WDN1) : PTR(bf16, w2, WS_WDN2), MP, D, FF, FF / 64}; pg8::StaticOrder S; S.init(MP, D, G, bx);
            EpiRes E{w2, 0.5f};
            __syncthreads();
            pg8::gemm_phase<EpiRes, pg8::StaticOrder, PG8_ALIGN, PG8_SP2>(lds, g, S, E, wave_s);
            pg8::Gemm g2{g.A, g.Bt, M, D, FF, SLICE_NT}; OrderSlice S2{G, bx}; EpiPart E2{w2};
            __syncthreads();
            pg8::gemm_phase<EpiPart, OrderSlice, PG8_ALIGN, PG8_SP2>(lds, g2, S2, E2, wave_s);
        }
        if (IN(ph + 1) && IN(ph + 2)) GRID_SYNC();
        if (pass == 1) break;
        if (IN(2)) {
            TIDS(); WSP(wf);
            const int gw = vcu * NWAVES + wave;
            if (gw < MSAMP) {
                f32x4 xn[4]; const float ss = sample_row_sum(wf, gw, lane, xn);
                u32x2* o8 = (u32x2*)(PTR(bf16, wf, WS_XB) + (size_t)(MP + gw) * D);
#pragma unroll
                for (int j = 0; j < 4; ++j) { u32x2 w; w.x = cvt_pk_bf16(xn[j][0], xn[j][1]); w.y = cvt_pk_bf16(xn[j][2], xn[j][3]); o8[lane + 64 * j] = w; }
                if (lane < 16) PTR(float, wf, WS_SSQ)[(size_t)(MP + gw) * 16 + lane] = lane == 0 ? ss : 0.f;
            }
        }
        if (IN(2) && IN(3)) GRID_SYNC();
        if (IN(3) && !SKIP_IN) {
            WSP(w3);
            pg8::Gemm g{PTR(bf16, w3, WS_XB), PTR(bf16, w3, WS_WIN), MA, N_INALL, D, D / 64}; OrderIn S; S.init(G, bx);
            EpiIn E{in, w3, out};
            __syncthreads();
            pg8::gemm_phase<EpiIn, OrderIn, PG8_ALIGN, PG8_SP2>(lds, g, S, E, wave_s);
#if PROBE_DUP == 3
            __syncthreads(); pg8::gemm_phase<EpiIn, OrderIn, PG8_ALIGN, PG8_SP2>(lds, g, S, E, wave_s);
#endif
        }
        if (IN(3) && IN(4)) GRID_SYNC();
        if (IN(4) && !SKIP_AT) {
            TIDS();
            WSP(w4);
            bf16 *KAS = PTR(bf16, w4, WS_KAS), *VTAS = PTR(bf16, w4, WS_VTAS), *KBS = PTR(bf16, w4, WS_KBS), *VTBS = PTR(bf16, w4, WS_VTBS), *MKS = PTR(bf16, w4, WS_MKS),
                 *MVTS = PTR(bf16, w4, WS_MVTS), *MKP = PTR(bf16, w4, WS_MKP), *MVTP = PTR(bf16, w4, WS_MVTP), *KAP = PTR(bf16, w4, WS_KAP), *VTAP = PTR(bf16, w4, WS_VTAP),
                 *KBP = PTR(bf16, w4, WS_KBP), *VTBP = PTR(bf16, w4, WS_VTBP), *QB = PTR(bf16, w4, WS_Q), *YB = PTR(bf16, w4, WS_Y);
            LAS float* biasl = (LAS float*)(lds + BIAS_OFF);
            for (int i = tid; i < 4 * 257; i += NTHREADS) biasl[i] = in[20][i] * LOG2E;
            __syncthreads();
            const int lane_o = lane;
            const int half = wave & 1, w2 = wave >> 1;
#if PROBE_DUP == 4
            for (int rep_ = 0; rep_ < 2; ++rep_)
#endif
            for (int ui_ = 0; ui_ < (G == 256 ? 19 : 4160); ++ui_) {
                int un;
                if (G == 256) {
                    const int v = vcu;
                    if (ui_ < 4) un = 256 * ui_ + (v & ~63) + ((v + 16 * ui_) & 63);
                    else if (ui_ == 4) un = v < 16 ? 1024 + v : -1;
                    else if (ui_ < 9) un = 1040 + v + 256 * (ui_ - 5);
                    else if (ui_ == 9) un = v >= 240 ? 2064 + (v - 240) : -1;
                    else { const int j = ui_ - 10, w = v - 16, n = v < 16 ? 5 : 8 + (w < 80 ? 1 : 0), st = v < 16 ? 5 * v : 80 + 8 * w + (w < 80 ? w : 80);
                        un = j < n ? 2080 + st + j : -1; }
                    if (un < 0) continue;
                } else { un = vcu + ui_ * G; if (un >= 4160) break; }
                if (un < 1040) {
                    const int bc = un, h = w2; const bf16 *Kp, *Vtp; int nt;
                    if (bc < 1024) { const int b = bc >> 6, c = bc & 63, cs = c > 8 ? c - 8 : 0; nt = c - cs + 1;
                        const size_t so = (size_t)(b * 4 + h) * 4096 * 64 + (size_t)cs * 4096; Kp = KBP + so; Vtp = VTBP + so; }
                    else { const int sb = bc - 1024; nt = 9; const size_t so = (size_t)(sb * 4 + h) * 576 * 64; Kp = KBS + so; Vtp = VTBS + so; }
                    attn_task(QB + (size_t)(bc * 64 + half * 32) * D + 512 + h * 64, Kp, Vtp, nt, false, 0.f, true, biasl + h * 257, nt - 1, half * 32,
                              YB + (size_t)(bc * 64 + half * 32) * D + 512 + h * 64, lane_o);
                } else if (un < 2080) {
                    const int bc = un - 1040, h = w2; const bf16 *Kp, *Vtp;
                    if (bc < 1024) { const int b = bc >> 6; const size_t so = (size_t)(b * 4 + h) * 256 * 64; Kp = MKP + so; Vtp = MVTP + so; }
                    else { const int sb = bc - 1024; const size_t so = (size_t)(sb * 4 + h) * 256 * 64; Kp = MKS + so; Vtp = MVTS + so; }
                    attn_task(QB + (size_t)(bc * 64 + half * 32) * D + 768 + h * 64, Kp, Vtp, 4, false, 0.f, false, biasl, 0, 0,
                              YB + (size_t)(bc * 64 + half * 32) * D + 768 + h * 64, lane_o);
                } else {
                    const int u2 = un - 2080, bc = u2 >> 1, kvh = u2 & 1, hq = 4 * kvh + w2; const bf16 *Kp, *Vtp; int nt;
                    if (bc < 1024) { const int b = bc >> 6, c = bc & 63, cs = c > 2 ? c - 2 : 0; nt = c - cs + 1;
                        const size_t so = (size_t)(b * 2 + kvh) * 4096 * 64 + (size_t)cs * 4096; Kp = KAP + so; Vtp = VTAP + so; }
                    else { const int sb = bc - 1024; nt = 3; const size_t so = (size_t)(sb * 2 + kvh) * 192 * 64; Kp = KAS + so; Vtp = VTAS + so; }
                    attn_task(QB + (size_t)(bc * 64 + half * 32) * D + hq * 64, Kp, Vtp, nt, true, in[17][hq] * LOG2E, false, biasl, 0, 0,
                              YB + (size_t)(bc * 64 + half * 32) * D + hq * 64, lane_o);
                }
            }
        }
        if (IN(4) && IN(5)) GRID_SYNC();
        if (IN(5) && !SKIP_BR) {
            WSP(w5);
            pg8::Gemm g{PTR(bf16, w5, WS_Y), PTR(bf16, w5, WS_WBR), M, D, D, D / 64}; pg8::StaticOrder S; S.init(M, D, G, bx);
            EpiBr E{w5};
            __syncthreads();
            pg8::gemm_phase<EpiBr, pg8::StaticOrder, PG8_ALIGN, PG8_SP2>(lds, g, S, E, wave_s);
#if PROBE_DUP == 5
            __syncthreads(); pg8::gemm_phase<EpiBr, pg8::StaticOrder, PG8_ALIGN, PG8_SP2>(lds, g, S, E, wave_s);
#endif
        }
        if (IN(5) && IN(6)) GRID_SYNC();
        if (IN(6) && !SKIP_OUT) {
            WSP(w6);
            pg8::Gemm g{PTR(bf16, w6, WS_Q), PTR(bf16, w6, WS_WOUT), M, D, D, D / 64}; pg8::StaticOrder S; S.init(M, D, G, bx);
            EpiRes E{w6, 1.0f};
            __syncthreads();
            pg8::gemm_phase<EpiRes, pg8::StaticOrder, PG8_ALIGN, PG8_SP2>(lds, g, S, E, wave_s);
        }
        if (IN(6) && IN(7)) GRID_SYNC();
    }
    if (IN(9)) {
        TIDS();
        const int gw = vcu * NWAVES + wave, NGW = G * NWAVES;
        WSP(w9); const float* SSQ9 = PTR(float, w9, WS_SSQ);
        const f32x4* gf = (const f32x4*)in[35];
        f32x4 gg[4];
#pragma unroll
        for (int j = 0; j < 4; ++j) gg[j] = gf[lane + 64 * j];
        const bf16* XB9 = PTR(bf16, w9, WS_XB);
        for (int r = gw * 4; r < MP; r += NGW * 4) {
            u32x2 v[4][4]; f32x4 pr[4];
#pragma unroll
            for (int k = 0; k < 4; ++k) { pr[k] = *(const f32x4*)(SSQ9 + (size_t)(r + k) * 16 + 4 * (lane & 3));
#pragma unroll
                for (int j = 0; j < 4; ++j) v[k][j] = ((const u32x2*)(XB9 + (size_t)(r + k) * D))[lane + 64 * j]; }
#pragma unroll
            for (int k = 0; k < 4; ++k) {
                float s_ = (pr[k][0] + pr[k][1]) + (pr[k][2] + pr[k][3]); s_ += __shfl_xor(s_, 1); s_ += __shfl_xor(s_, 2);
                const float rs = rsqrtf(s_ * (1.0f / 1024.0f) + EPS);
                f32x4* p = (f32x4*)(out + (size_t)(r + k) * D);
#pragma unroll
                for (int j = 0; j < 4; ++j) { const f32x4 x = (f32x4){bf_lo(v[k][j].x), bf_hi(v[k][j].x), bf_lo(v[k][j].y), bf_hi(v[k][j].y)}; p[lane + 64 * j] = x * rs * gg[j]; }
            }
        }
        if (gw < MSAMP) {
            f32x4 xn[4]; const float ss = sample_row_sum(w9, gw, lane, xn);
            const float rs = rsqrtf(ss * (1.0f / 1024.0f) + EPS);
            f32x4* p = (f32x4*)(out + (size_t)(MP + gw) * D);
#pragma unroll
            for (int j = 0; j < 4; ++j) p[lane + 64 * j] = xn[j] * rs * gg[j];
        }
    }
#undef IN
}

extern "C" void kernel_launch(void* const* d_in, const int* in_sizes, int n_in, void* d_out, int out_size, void* d_ws, size_t ws_size, hipStream_t stream) {
    static int grid = 0;
    if (grid == 0) {
        if (n_in != 36 || ws_size < WS_END) { fprintf(stderr, "kernel_launch: unexpected n_in %d / ws_size %zu (need %zu)\n", n_in, ws_size, (size_t)WS_END); grid = -1; return; }
        int dev = 0, cus = 0, per_cu = 0;
        (void)hipGetDevice(&dev); (void)hipDeviceGetAttribute(&cus, hipDeviceAttributeMultiprocessorCount, dev);
        (void)hipFuncSetAttribute((const void*)mega, hipFuncAttributeMaxDynamicSharedMemorySize, LDS_BYTES);
        if (hipOccupancyMaxActiveBlocksPerMultiprocessor(&per_cu, (const void*)mega, NTHREADS, LDS_BYTES) != hipSuccess || per_cu < 1) per_cu = 1;
        (void)hipGetLastError();
        if (per_cu > 1) per_cu = 1;
        grid = cus * per_cu; if (grid <= 0) grid = 256;
    }
    if (grid < 0) return;
    Args a{};
    for (int i = 0; i < 36; ++i) a.in[i] = (const float*)d_in[i];
    a.out = (float*)d_out; a.ws = (unsigned char*)d_ws;
#if MK_MULTI
    for (int p = 0; p < 10; ++p) { a.ph_lo = p; a.ph_hi = p + 1; hipLaunchKernelGGL(mega, dim3(grid), dim3(NTHREADS), LDS_BYTES, stream, a); }
#else
    a.ph_lo = 0; a.ph_hi = 10;
    (void)hipMemsetAsync(d_ws, 0, 16384, stream);
    void* kargs[] = {&a};
    hipError_t e = hipLaunchCooperativeKernel((const void*)mega, dim3(grid), dim3(NTHREADS), kargs, LDS_BYTES, stream);
    if (e != hipSuccess) fprintf(stderr, "cooperative launch failed: %s (grid %d)\n", hipGetErrorString(e), grid);
#endif
}
```

```cpp
#include <hip/hip_runtime.h>
#include <hip/hip_cooperative_groups.h>
#include <cstdio>
#include <cstdint>
namespace cg = cooperative_groups;
__device__ __forceinline__ int lane_id() { int l; asm volatile("v_mbcnt_lo_u32_b32 %0, -1, 0\n\tv_mbcnt_hi_u32_b32 %0, -1, %0" : "=v"(l)); return l; }
namespace pg8 {
#define PG8_LAS __attribute__((address_space(3)))
typedef unsigned short bf16_t;
typedef short bf16x8 __attribute__((ext_vector_type(8)));
typedef float f32x4 __attribute__((ext_vector_type(4)));
typedef unsigned u32x4 __attribute__((ext_vector_type(4)));
constexpr int BM = 256, BK = 64, HALF = 128, HTB = HALF * BK * 2  , STAGE_BYTES = 8 * HTB, NXCD = 8, WGM = 8;

__host__ __device__ __forceinline__ int lds_byte(int r, int c) { const int st = (r >> 4) * 2 + (c >> 5), rr = r & 15, cc = c & 31, ob = rr * 64 + cc * 2; return st * 1024 + (ob ^ (((ob >> 9) & 1) << 5)); }
__host__ __device__ __forceinline__ void stage_rc(int b, int& R, int& C) { const int st = b / 1024, sb = b % 1024, swz = sb ^ (((sb >> 9) & 1) << 5); R = (st >> 1) * 16 + swz / 64; C = (st & 1) * 32 + (swz % 64) / 2; }
__host__ __device__ __forceinline__ int perm32(int rho) { const int n = rho >> 4, i = rho & 15; return 8 * (i >> 2) + 4 * n + (i & 3); }

struct Unit { int pm, pn, ks; };
struct Gemm { const bf16_t* A; const bf16_t* Bt; int M, N, K, nt; };

struct StaticOrder {
    int nM, nN, nwg, G, c;
    __host__ __device__ void init(int M, int N, int G_, int c_) { nM = M / BM; nN = N / BM; nwg = nM * nN; G = G_; c = c_; }
    __host__ __device__ bool next(int i, Unit& u) const {
        const long L = (long)i * G + c; if (L >= nwg) return false;
        int wgid = (int)L; { const int q = nwg / NXCD, r = nwg % NXCD, xcd = wgid % NXCD, off = wgid / NXCD; wgid = (xcd < r ? xcd * (q + 1) : r * (q + 1) + (xcd - r) * q) + off; }
        const int nig = WGM * nN, gid = wgid / nig, fm = gid * WGM, gsz = (nM - fm) < WGM ? (nM - fm) : WGM;
        u.pm = fm + ((wgid % nig) % gsz); u.pn = (wgid % nig) / gsz; u.ks = 0; return true;
    }
    __device__ __forceinline__ void a_ready(const Unit&) const {}
    __device__ __forceinline__ void done(const Unit&) const {}
};

typedef float cvt_f32x2_t __attribute__((ext_vector_type(2))); typedef __bf16 cvt_bf16x2_t __attribute__((ext_vector_type(2)));
__device__ __forceinline__ unsigned cvt_pk_bf16(float lo, float hi) { const cvt_f32x2_t v = {lo, hi}; const cvt_bf16x2_t b = __builtin_convertvector(v, cvt_bf16x2_t); return __builtin_bit_cast(unsigned, b); }
template <class Epi, class Sched, bool ALIGN_EPI = false, bool SP2 = false>
__device__ __forceinline__ void gemm_phase(PG8_LAS unsigned char* lds, const Gemm g, const Sched& S, const Epi& E, int wave_s) {
    int tid_o = wave_s * 64 + lane_id(); asm volatile("" : "+v"(tid_o));
    const int tid = tid_o, wid = __builtin_amdgcn_readfirstlane(tid >> 6), lane = tid & 63, wr = wid >> 2, wc = wid & 3, fr = lane & 15, fq = lane >> 4;
    const int K = g.K, nt = g.nt;
    unsigned voffA[2], voffB[2];
#pragma unroll
    for (int i = 0; i < 2; ++i) { int R, C; stage_rc(tid * 16 + i * 8192, R, C); const int Rb = Epi::PERM ? ((R & ~31) + perm32(R & 31)) : R;
        voffA[i] = (unsigned)(R * K + C) * 2u; voffB[i] = (unsigned)(Rb * K + C) * 2u; }
    const size_t kstep = (size_t)(BK * 2);
    const size_t hstep = (size_t)HALF * K * 2;
    const size_t tstep = 2 * hstep;
    const unsigned ldsw = (unsigned)wid * 1024u;
    const int aoff = lds_byte(wr * 64 + fr, fq * 8), boff = lds_byte(wc * 32 + fr, fq * 8);
#define PG8_SA(b, h) (((b) * 2 + (h)) * HTB)
#define PG8_SB(b, h) ((4 + (b) * 2 + (h)) * HTB)
#define PG8_STAGE(bufoff, gbase, voff) do { _Pragma("unroll") for (int _i = 0; _i < 2; ++_i) \
        __builtin_amdgcn_global_load_lds((const unsigned*)((const char*)(gbase) + (voff)[_i]), (PG8_LAS unsigned*)(lds + (bufoff) + ldsw + _i * 8192), 16, 0, 0); } while (0)
#define PG8_LDA(dst, b, h) do { _Pragma("unroll") for (int m = 0; m < 4; ++m) _Pragma("unroll") for (int k = 0; k < 2; ++k) dst[m][k] = *(const PG8_LAS bf16x8*)(lds + PG8_SA(b, h) + aoff + m * 2048 + k * 1024); } while (0)
#define PG8_LDB(dst, b, h) do { _Pragma("unroll") for (int n = 0; n < 2; ++n) _Pragma("unroll") for (int k = 0; k < 2; ++k) dst[n][k] = *(const PG8_LAS bf16x8*)(lds + PG8_SB(b, h) + boff + n * 2048 + k * 1024); } while (0)
#define PG8_MMA(ai, bj, At, Bt) do { __builtin_amdgcn_s_setprio(1); _Pragma("unroll") for (int m = 0; m < 4; ++m) _Pragma("unroll") for (int n = 0; n < 2; ++n) _Pragma("unroll") for (int k = 0; k < 2; ++k) \
        acc[ai][bj][m][n] = __builtin_amdgcn_mfma_f32_16x16x32_bf16(Bt[n][k], At[m][k], acc[ai][bj][m][n], 0, 0, 0); __builtin_amdgcn_s_setprio(0); } while (0)
#define PG8_WAIT_V(n) asm volatile("s_waitcnt vmcnt(" #n ")" ::: "memory")
#define PG8_WAIT_L(n) asm volatile("s_waitcnt lgkmcnt(" #n ")" ::: "memory")
#define PG8_BAR __builtin_amdgcn_s_barrier()
#define PG8_SCHED __builtin_amdgcn_sched_barrier(0)
    Unit cur, nxt; int ui = 0;
    int rs_t = 2; asm volatile("" : "+s"(rs_t));
    if (!S.next(0, cur)) return;
    f32x4 acc[2][2][4][2];
#pragma unroll
    for (int a = 0; a < 2; ++a)
#pragma unroll
        for (int b = 0; b < 2; ++b)
#pragma unroll
            for (int m = 0; m < 4; ++m)
#pragma unroll
                for (int n = 0; n < 2; ++n) acc[a][b][m][n] = (f32x4){0.f, 0.f, 0.f, 0.f};
    bf16x8 At[4][2], B0[2][2], B1[2][2];
    const size_t sstep = (size_t)nt * kstep;
    const char* cA = (const char*)g.A + (size_t)cur.pm * tstep + (size_t)cur.ks * sstep; const char* cB = (const char*)g.Bt + (size_t)cur.pn * tstep + (size_t)cur.ks * sstep;
    S.a_ready(cur);
    if constexpr (SP2) {
        PG8_STAGE(PG8_SB(0, 0), cB, voffB); PG8_STAGE(PG8_SB(0, 1), cB + hstep, voffB); PG8_STAGE(PG8_SA(0, 0), cA, voffA); PG8_STAGE(PG8_SA(0, 1), cA + hstep, voffA);
        if (wr == 1) PG8_BAR;
        PG8_WAIT_V(2); PG8_BAR;
        PG8_STAGE(PG8_SB(1, 0), cB + kstep, voffB); PG8_STAGE(PG8_SA(1, 0), cA + kstep, voffA); PG8_STAGE(PG8_SB(1, 1), cB + hstep + kstep, voffB);
        PG8_WAIT_V(6); PG8_BAR;
    } else {
        PG8_STAGE(PG8_SB(0, 0), cB, voffB); PG8_STAGE(PG8_SA(0, 0), cA, voffA); PG8_STAGE(PG8_SB(0, 1), cB + hstep, voffB); PG8_STAGE(PG8_SA(0, 1), cA + hstep, voffA);
        if (wr == 1) PG8_BAR;
        PG8_WAIT_V(4); PG8_BAR;
        PG8_STAGE(PG8_SB(1, 0), cB + kstep, voffB); PG8_STAGE(PG8_SA(1, 0), cA + kstep, voffA); PG8_STAGE(PG8_SB(1, 1), cB + hstep + kstep, voffB);
        PG8_WAIT_V(6); PG8_BAR;
    }
    for (;;) {
        const bool has_next = S.next(ui + 1, nxt);
        const char* nA = has_next ? (const char*)g.A + (size_t)nxt.pm * tstep + (size_t)nxt.ks * sstep : cA; const char* nB = has_next ? (const char*)g.Bt + (size_t)nxt.pn * tstep + (size_t)nxt.ks * sstep : cB;
        for (int t = 0; t < nt; t += 2) {
            if constexpr (Epi::HOOK) { if (t == 8 || t == 12) E.hook(acc, cur, t, wr, wc, fr, fq); }
            typename Epi::RsT rsr;
            if constexpr (Epi::RSLDS) { if (t == rs_t) E.rs_issue(cur, wid, lane, rsr); }
            const bool last = (t == nt - 2);
            const char* a1 = cA + (size_t)(t + 1) * kstep;
            const char* a2 = last ? nA : cA + (size_t)(t + 2) * kstep; const char* b2 = last ? nB : cB + (size_t)(t + 2) * kstep;
            const char* a3 = a2 + kstep; const char* b3 = b2 + kstep;
            if (last && has_next) S.a_ready(nxt);
            if constexpr (SP2) {
            PG8_LDB(B0, 0, 0); PG8_LDB(B1, 0, 1); PG8_SCHED; PG8_LDA(At, 0, 0); PG8_STAGE(PG8_SA(1, 1), a1 + hstep, voffA);
            PG8_WAIT_V(8); PG8_WAIT_L(0); PG8_BAR; PG8_MMA(0, 0, At, B0); PG8_MMA(0, 1, At, B1); PG8_BAR; PG8_SCHED;
            PG8_LDA(At, 0, 1); PG8_STAGE(PG8_SB(0, 0), b2, voffB); PG8_STAGE(PG8_SB(0, 1), b2 + hstep, voffB); PG8_STAGE(PG8_SA(0, 0), a2, voffA);
            PG8_WAIT_V(8); PG8_WAIT_L(0); PG8_BAR; PG8_MMA(1, 0, At, B0); PG8_MMA(1, 1, At, B1); PG8_BAR; PG8_SCHED;
            PG8_LDB(B0, 1, 0); PG8_LDB(B1, 1, 1); PG8_SCHED; PG8_LDA(At, 1, 0); PG8_STAGE(PG8_SA(0, 1), a2 + hstep, voffA);
            PG8_WAIT_V(8); PG8_WAIT_L(0); PG8_BAR; PG8_MMA(0, 0, At, B0); PG8_MMA(0, 1, At, B1); PG8_BAR; PG8_SCHED;
            PG8_LDA(At, 1, 1); PG8_STAGE(PG8_SB(1, 0), b3, voffB); PG8_STAGE(PG8_SB(1, 1), b3 + hstep, voffB); PG8_STAGE(PG8_SA(1, 0), a3, voffA);
            PG8_WAIT_V(8); PG8_WAIT_L(0); PG8_BAR; PG8_MMA(1, 0, At, B0); PG8_MMA(1, 1, At, B1); PG8_BAR; PG8_SCHED;
            } else {
            PG8_LDB(B0, 0, 0); PG8_SCHED; PG8_LDA(At, 0, 0); PG8_STAGE(PG8_SA(1, 1), a1 + hstep, voffA);
            PG8_WAIT_L(8); PG8_BAR; PG8_WAIT_L(0); PG8_MMA(0, 0, At, B0); PG8_BAR; PG8_SCHED;
            PG8_LDB(B1, 0, 1); PG8_STAGE(PG8_SB(0, 0), b2, voffB);
            PG8_BAR; PG8_WAIT_L(0); PG8_MMA(0, 1, At, B1); PG8_BAR;
            PG8_LDA(At, 0, 1); PG8_STAGE(PG8_SA(0, 0), a2, voffA);
            PG8_BAR; PG8_WAIT_L(0); PG8_MMA(1, 0, At, B0); PG8_BAR; PG8_SCHED;
            PG8_STAGE(PG8_SB(0, 1), b2 + hstep, voffB);
            PG8_WAIT_V(6); PG8_BAR; PG8_MMA(1, 1, At, B1); PG8_BAR;
            PG8_LDB(B0, 1, 0); PG8_SCHED; PG8_LDA(At, 1, 0); PG8_STAGE(PG8_SA(0, 1), a2 + hstep, voffA);
            PG8_WAIT_L(8); PG8_BAR; PG8_WAIT_L(0); PG8_MMA(0, 0, At, B0); PG8_BAR; PG8_SCHED;
            PG8_LDB(B1, 1, 1); PG8_STAGE(PG8_SB(1, 0), b3, voffB);
            PG8_BAR; PG8_WAIT_L(0); PG8_MMA(0, 1, At, B1); PG8_BAR;
            PG8_LDA(At, 1, 1); PG8_STAGE(PG8_SA(1, 0), a3, voffA);
            PG8_BAR; PG8_WAIT_L(0); PG8_MMA(1, 0, At, B0); PG8_BAR; PG8_SCHED;
            PG8_STAGE(PG8_SB(1, 1), b3 + hstep, voffB);
            PG8_WAIT_V(6); PG8_BAR; PG8_MMA(1, 1, At, B1); PG8_BAR;
            }
            if constexpr (Epi::RSLDS) { if (t == rs_t) E.rs_finish(lds, wid, lane, rsr); }
        }
        if constexpr (ALIGN_EPI) { if (wr == 0) PG8_BAR; }
        if constexpr (!Epi::AFTER_DRAIN) { E(acc, cur, wr, wc, fr, fq); S.done(cur); }
        if (!has_next) break;
#pragma unroll
        for (int a = 0; a < 2; ++a)
#pragma unroll
            for (int b = 0; b < 2; ++b)
#pragma unroll
                for (int m = 0; m < 4; ++m)
#pragma unroll
                    for (int n = 0; n < 2; ++n) acc[a][b][m][n] = (f32x4){0.f, 0.f, 0.f, 0.f};
        cur = nxt; cA = nA; cB = nB; ++ui;
        if constexpr (ALIGN_EPI) { if (wr == 1) PG8_BAR; }
    }
    PG8_WAIT_V(0);
    if constexpr (!ALIGN_EPI) { if (wr == 0) PG8_BAR; }
    PG8_BAR;
    if constexpr (Epi::AFTER_DRAIN) { E.fused(acc, cur, wr, wc, fr, fq, lds, wid, lane); S.done(cur); }
#undef PG8_SA
#undef PG8_SB
#undef PG8_STAGE
#undef PG8_LDA
#undef PG8_LDB
#undef PG8_MMA
#undef PG8_WAIT_V
#undef PG8_WAIT_L
#undef PG8_BAR
#undef PG8_SCHED
}
}
#ifndef PG8_SP2
#define PG8_SP2 true
#endif
#ifndef PG8_ALIGN
#define PG8_ALIGN true
#endif
#ifndef SKIP_UP
#define SKIP_UP 0
#endif
#ifndef SKIP_DN
#define SKIP_DN 0
#endif
#ifndef SKIP_IN
#define SKIP_IN 0
#endif
#ifndef SKIP_AT
#define SKIP_AT 0
#endif
#ifndef SKIP_BR
#define SKIP_BR 0
#endif
#ifndef SKIP_OUT
#define SKIP_OUT 0
#endif
#ifndef SKIP_P0
#define SKIP_P0 0
#endif
#ifndef PROBE_DUP
#define PROBE_DUP 0
#endif
#ifndef MK_MULTI
#define MK_MULTI 0
#endif

#define LAS __attribute__((address_space(3)))
typedef unsigned short bf16;
typedef short bf16x8 __attribute__((ext_vector_type(8)));
typedef float f32x4 __attribute__((ext_vector_type(4)));
typedef float f32x2 __attribute__((ext_vector_type(2)));
typedef float f32x16 __attribute__((ext_vector_type(16)));
typedef unsigned u32x4 __attribute__((ext_vector_type(4)));
typedef unsigned u32x2 __attribute__((ext_vector_type(2)));

constexpr int D = 1024, FF = 2816, MP = 65536, MSAMP = 1024, M = MP + MSAMP, MMEM = 4096, MA = M + MMEM;
constexpr int N_UP = 2 * FF, N_IN = 4864, N_INALL = 5376;
constexpr float EPS = 1e-6f, LOG2E = 1.4426950408889634f, C2 = 0.125f * 1.4426950408889634f;
constexpr int NWAVES = 8, NTHREADS = 512;
constexpr int RING_BYTES = 131072, BIAS_OFF = RING_BYTES + 1024, LDS_BYTES = 147456;

constexpr size_t MiB = 1u << 20;
constexpr size_t WS_ROPE = 1 * MiB, WS_SSQ = 2 * MiB, WS_WUP1 = 8 * MiB, WS_WDN1 = 20 * MiB, WS_WUP2 = 26 * MiB, WS_WDN2 = 38 * MiB, WS_WIN = 44 * MiB,
                 WS_WBR = 56 * MiB, WS_WOUT = 58 * MiB, WS_KAS = 60 * MiB, WS_VTAS = 61 * MiB, WS_KBS = 62 * MiB, WS_VTBS = 67 * MiB, WS_MKS = 72 * MiB,
                 WS_MVTS = 74 * MiB, WS_MKP = 76 * MiB, WS_MVTP = 78 * MiB, WS_XB = 80 * MiB, WS_KAP = 218 * MiB, WS_VTAP = 234 * MiB, WS_KBP = 250 * MiB,
                 WS_VTBP = 282 * MiB, WS_Q = 314 * MiB, WS_Y = 444 * MiB, WS_H = 574 * MiB, WS_PART = 964 * MiB, WS_END = 1010 * MiB;
static_assert(WS_XB + (size_t)MA * D * 2 <= WS_KAP && WS_Q + (size_t)M * D * 2 <= WS_Y && WS_Y + (size_t)M * D * 2 <= WS_H && WS_H + (size_t)M * 3072 * 2 <= WS_PART && WS_PART + (size_t)11 * 1024 * 1024 * 4 <= WS_END, "ws map");
constexpr size_t OFF_AKP = 68157440, OFF_AVP = 68419584, OFF_BKP = 68681728, OFF_BVP = 70778880, OFF_MKP = 72876032, OFF_MVP = 73924608,
                 OFF_AKS = 74973184, OFF_AVS = 75104256, OFF_BKS = 75235328, OFF_BVS = 75497472;

using pg8::Unit;
using pg8::cvt_pk_bf16;

__device__ __forceinline__ float row_rs(const float* ssq, int row) {
    const f32x4* p = (const f32x4*)(ssq + (size_t)row * 16);
    const f32x4 a = p[0], b = p[1], c = p[2], d = p[3];
    const f32x4 s = (a + b) + (c + d);
    return rsqrtf(((s[0] + s[1]) + (s[2] + s[3])) * (1.0f / 1024.0f) + EPS);
}
__device__ __forceinline__ void load_rs8(const float* ssq, int row0, int fq, float (&rs)[2][4]) {
    f32x4 t[2][4];
#pragma unroll
    for (int ai = 0; ai < 2; ++ai)
#pragma unroll
        for (int m = 0; m < 4; ++m) t[ai][m] = *(const f32x4*)(ssq + (size_t)(row0 + ai * 128 + m * 16) * 16 + 4 * fq);
#pragma unroll
    for (int ai = 0; ai < 2; ++ai)
#pragma unroll
        for (int m = 0; m < 4; ++m) { float s_ = (t[ai][m][0] + t[ai][m][1]) + (t[ai][m][2] + t[ai][m][3]); s_ += __shfl_xor(s_, 16); s_ += __shfl_xor(s_, 32);
            rs[ai][m] = rsqrtf(s_ * (1.0f / 1024.0f) + EPS); }
}
constexpr int RS_LDS_OFF = 131072 + 6144;
struct NoRs {};
struct RsReg { f32x4 a, b; };
__device__ __forceinline__ void rs_issue_regs(const float* ssq, int pm, int wid, int lane, RsReg& r) {
    const f32x4* p = (const f32x4*)(ssq + (size_t)(pm * 256 + 32 * wid + (lane >> 1)) * 16 + 8 * (lane & 1)); r.a = p[0]; r.b = p[1];
}
__device__ __forceinline__ void rs_finish_lds(__attribute__((address_space(3))) unsigned char* lds, int wid, int lane, const RsReg& r) {
    float s_ = ((r.a[0] + r.a[1]) + (r.a[2] + r.a[3])) + ((r.b[0] + r.b[1]) + (r.b[2] + r.b[3])); s_ += __shfl_xor(s_, 1);
    if (!(lane & 1)) ((__attribute__((address_space(3))) float*)(lds + RS_LDS_OFF))[32 * wid + (lane >> 1)] = rsqrtf(s_ * (1.0f / 1024.0f) + EPS);
}
__device__ __forceinline__ void rs_fill_lds(const float* ssq, int pm, __attribute__((address_space(3))) unsigned char* lds, int wid, int lane) {
    const int r = 32 * wid + (lane >> 1);
    const f32x4* p = (const f32x4*)(ssq + (size_t)(pm * 256 + r) * 16 + 8 * (lane & 1));
    const f32x4 a = p[0], b = p[1];
    float s_ = ((a[0] + a[1]) + (a[2] + a[3])) + ((b[0] + b[1]) + (b[2] + b[3])); s_ += __shfl_xor(s_, 1);
    if (!(lane & 1)) ((__attribute__((address_space(3))) float*)(lds + RS_LDS_OFF))[r] = rsqrtf(s_ * (1.0f / 1024.0f) + EPS);
}
__device__ __forceinline__ void rs_read_lds(int wr, int fr, float (&rs)[2][4]) {
    const __attribute__((address_space(3))) float* t = (const __attribute__((address_space(3))) float*)(uintptr_t)RS_LDS_OFF;
#pragma unroll
    for (int ai = 0; ai < 2; ++ai)
#pragma unroll
        for (int m = 0; m < 4; ++m) rs[ai][m] = t[ai * 128 + wr * 64 + m * 16 + fr];
}
__device__ __forceinline__ float fq_sum(float v) {
    const auto a = __builtin_amdgcn_permlane16_swap(__float_as_uint(v), __float_as_uint(v), false, false);
    const float s1 = __uint_as_float(a[0]) + __uint_as_float(a[1]);
    const auto b = __builtin_amdgcn_permlane32_swap(__float_as_uint(s1), __float_as_uint(s1), false, false);
    return __uint_as_float(b[0]) + __uint_as_float(b[1]);
}
__device__ __forceinline__ float bf_lo(unsigned w) { return __uint_as_float(w << 16); }
__device__ __forceinline__ float bf_hi(unsigned w) { return __uint_as_float(w & 0xffff0000u); }
__device__ __forceinline__ int kf_off(int t, int d) { return ((t >> 5) * 4 + (d >> 4)) * 512 + ((((d >> 3) & 1) * 32) + (t & 31)) * 8 + (d & 7); }
__device__ __forceinline__ int vf_off(int t, int d) { const int kvl = t & 15, hi = (kvl >> 2) & 1, e = ((kvl >> 3) << 2) | (kvl & 3);
    return (((t >> 6) * 2 + (d >> 5)) * 4 + ((t >> 4) & 3)) * 512 + (hi * 32 + (d & 31)) * 8 + e; }
__device__ __forceinline__ size_t gate_off8(int pm, int t, int ai, int m, int bj, int tid) { return ((((size_t)pm * 12 + t) * 16 + (ai * 4 + m) * 2 + bj) * 512 + tid) * 8; }
__device__ __forceinline__ float ub(unsigned w, int k) { return (float)((w >> (8 * k)) & 0xffu); }
__device__ __forceinline__ float sigm(float z) { return __builtin_amdgcn_rcpf(1.0f + __builtin_amdgcn_exp2f(-z * LOG2E)); }

struct EpiUp {
    static constexpr bool PERM = true, AFTER_DRAIN = false, HOOK = false, RSLDS = true;
    unsigned char* ws;
    typedef RsReg RsT;
    __device__ __forceinline__ void rs_issue(const Unit& u, int wid, int lane, RsReg& r) const { rs_issue_regs((const float*)(ws + WS_SSQ), u.pm, wid, lane, r); }
    __device__ __forceinline__ void rs_finish(__attribute__((address_space(3))) unsigned char* lds, int wid, int lane, const RsReg& r) const { rs_finish_lds(lds, wid, lane, r); }
    __device__ __forceinline__ void operator()(const f32x4 (&acc)[2][2][4][2], const Unit& u, int wr, int wc, int fr, int fq) const {
        const float* ssq = (const float*)(ws + WS_SSQ); bf16* H = (bf16*)(ws + WS_H);
        const int row0 = u.pm * 256 + wr * 64 + fr, col0 = u.pn * 128 + wc * 32 + 8 * fq;
        float rsv[2][4]; rs_read_lds(wr, fr, rsv); (void)ssq;
#pragma unroll
        for (int ai = 0; ai < 2; ++ai)
#pragma unroll
            for (int m = 0; m < 4; ++m) {
                const int row = row0 + ai * 128 + m * 16; const float rs = rsv[ai][m];
                const float k1 = -rs * LOG2E, k2 = rs * rs;
                float h[8];
#pragma unroll
                for (int n = 0; n < 2; ++n)
#pragma unroll
                    for (int e2 = 0; e2 < 2; ++e2) {
                        const f32x2 ag = (f32x2){acc[ai][0][m][n][2 * e2], acc[ai][0][m][n][2 * e2 + 1]}, au = (f32x2){acc[ai][1][m][n][2 * e2], acc[ai][1][m][n][2 * e2 + 1]};
                        const f32x2 ea = ag * k1; f32x2 ex; ex.x = __builtin_amdgcn_exp2f(ea.x); ex.y = __builtin_amdgcn_exp2f(ea.y);
                        const f32x2 den = ex + 1.0f; f32x2 sg; sg.x = __builtin_amdgcn_rcpf(den.x); sg.y = __builtin_amdgcn_rcpf(den.y);
                        const f32x2 hh = ((ag * au) * k2) * sg;
                        h[4 * n + 2 * e2] = hh.x; h[4 * n + 2 * e2 + 1] = hh.y; }
                u32x4 w; w.x = cvt_pk_bf16(h[0], h[1]); w.y = cvt_pk_bf16(h[2], h[3]); w.z = cvt_pk_bf16(h[4], h[5]); w.w = cvt_pk_bf16(h[6], h[7]);
                __builtin_nontemporal_store(w, (u32x4*)(H + (size_t)row * FF + col0));
            }
    }
};
struct EpiRes {
    static constexpr bool PERM = true, AFTER_DRAIN = false, HOOK = false, RSLDS = false;
    typedef NoRs RsT;
    unsigned char* ws; float scale;
    __device__ __forceinline__ void operator()(const f32x4 (&acc)[2][2][4][2], const Unit& u, int wr, int wc, int fr, int fq) const {
        bf16* xb = (bf16*)(ws + WS_XB); float* ssq = (float*)(ws + WS_SSQ);
        const int row0 = u.pm * 256 + wr * 64 + fr, col0 = u.pn * 256 + wc * 32 + 8 * fq;
        u32x4 old[2][4][2];
#pragma unroll
        for (int ai = 0; ai < 2; ++ai)
#pragma unroll
            for (int m = 0; m < 4; ++m)
#pragma unroll
                for (int bj = 0; bj < 2; ++bj) old[ai][m][bj] = *(const u32x4*)(xb + (size_t)(row0 + ai * 128 + m * 16) * D + col0 + bj * 128);
#pragma unroll
        for (int ai = 0; ai < 2; ++ai)
#pragma unroll
            for (int m = 0; m < 4; ++m) {
                const int row = row0 + ai * 128 + m * 16; f32x2 ss2 = (f32x2){0.f, 0.f};
#pragma unroll
                for (int bj = 0; bj < 2; ++bj) { const u32x4 o = old[ai][m][bj]; u32x4 w;
#pragma unroll
                    for (int j = 0; j < 4; ++j) {
                        const f32x2 a2 = (f32x2){acc[ai][bj][m][j >> 1][(j & 1) * 2], acc[ai][bj][m][j >> 1][(j & 1) * 2 + 1]};
                        const f32x2 n2 = a2 * scale + (f32x2){bf_lo(o[j]), bf_hi(o[j])};
                        ss2 += n2 * n2; w[j] = cvt_pk_bf16(n2.x, n2.y); }
                    *(u32x4*)(xb + (size_t)row * D + col0 + bj * 128) = w; }
                float ss = ss2.x + ss2.y;
                ss = fq_sum(ss);
                if (fq == 0) ssq[(size_t)row * 16 + u.pn * 4 + wc] = ss;
            }
    }
};
struct EpiIn {
    static constexpr bool PERM = true, AFTER_DRAIN = false, HOOK = false, RSLDS = true;
    const float* const* in; unsigned char* ws; float* out;
    typedef RsReg RsT;
    __device__ __forceinline__ void rs_issue(const Unit& u, int wid, int lane, RsReg& r) const { rs_issue_regs((const float*)(ws + WS_SSQ), u.pm, wid, lane, r); }
    __device__ __forceinline__ void rs_finish(__attribute__((address_space(3))) unsigned char* lds, int wid, int lane, const RsReg& r) const { rs_finish_lds(lds, wid, lane, r); }
    __device__ __forceinline__ void operator()(const f32x4 (&acc)[2][2][4][2], const Unit& u, int wr, int wc, int fr, int fq) const {
        const float* ssq = (const float*)(ws + WS_SSQ); const f32x2* rope = (const f32x2*)(ws + WS_ROPE);
        bf16* Q = (bf16*)(ws + WS_Q); bf16* G = (bf16*)(ws + WS_H);
        int pm_o = u.pm, pn_o = u.pn; asm volatile("" : "+s"(pm_o), "+s"(pn_o), "+s"(wc), "+s"(wr), "+v"(fr), "+v"(fq));
        const int pm = pm_o, pn = pn_o, row0 = pm * 256 + wr * 64 + fr;
        float rsv[2][4]; rs_read_lds(wr, fr, rsv); (void)ssq;
        if (pn >= 7 && pn < 19) {
            const int col0 = (pn - 7) * 256 + wc * 32 + 8 * fq;
            const float* b_gate = in[26];
            float bb[2][8];
#pragma unroll
            for (int bj = 0; bj < 2; ++bj)
#pragma unroll
                for (int i = 0; i < 8; ++i) bb[bj][i] = -LOG2E * b_gate[col0 + bj * 128 + i];
#pragma unroll
            for (int ai = 0; ai < 2; ++ai)
#pragma unroll
                for (int m = 0; m < 4; ++m) {
                    const int row = row0 + ai * 128 + m * 16; const float k1 = -LOG2E * rsv[ai][m];
#pragma unroll
                    for (int bj = 0; bj < 2; ++bj) { unsigned q[8];
#pragma unroll
                        for (int i2 = 0; i2 < 4; ++i2) {
                            const f32x2 a2 = (f32x2){acc[ai][bj][m][i2 >> 1][(i2 & 1) * 2], acc[ai][bj][m][i2 >> 1][(i2 & 1) * 2 + 1]};
                            const f32x2 ez = a2 * k1 + (f32x2){bb[bj][2 * i2], bb[bj][2 * i2 + 1]};
                            f32x2 ex; ex.x = __builtin_amdgcn_exp2f(ez.x); ex.y = __builtin_amdgcn_exp2f(ez.y);
                            const f32x2 den = ex + 1.0f; f32x2 sg; sg.x = __builtin_amdgcn_rcpf(den.x); sg.y = __builtin_amdgcn_rcpf(den.y);
                            const f32x2 qf = sg * 255.0f + 0.5f;
                            const unsigned q0 = (unsigned)qf.x, q1 = (unsigned)qf.y; q[2 * i2] = q0 < 1u ? 1u : q0; q[2 * i2 + 1] = q1 < 1u ? 1u : q1; }
                        u32x2 w; w.x = q[0] | (q[1] << 8) | (q[2] << 16) | (q[3] << 24); w.y = q[4] | (q[5] << 8) | (q[6] << 16) | (q[7] << 24);
                        __builtin_nontemporal_store(w, (u32x2*)((unsigned char*)G + gate_off8(pm, pn - 7, ai, m, bj, (wr * 4 + wc) * 64 + fq * 16 + fr))); (void)row; }
                }
            return;
        }
        int mode, mixer = 0, hh = wc, qcol = 0, gidx = -1; bool rope_on = false;
        if (pn <= 1)       { mode = 0; gidx = 15; rope_on = true; qcol = (4 * pn + wc) * 64; }
        else if (pn == 2)  { mixer = 0; if (wc < 2) { mode = 1; gidx = 16; rope_on = true; hh = wc; } else { mode = 2; hh = wc - 2; } }
        else if (pn == 3)  { mode = 0; gidx = 18; qcol = 512 + wc * 64; }
        else if (pn == 4)  { mode = 1; gidx = 19; mixer = 1; }
        else if (pn == 5)  { mode = 2; mixer = 1; }
        else if (pn == 6)  { mode = 0; gidx = 21; qcol = 768 + wc * 64; }
        else if (pn == 19) { mode = 1; gidx = 24; mixer = 2; }
        else               { mode = 2; mixer = 2; }
        const float* gain = gidx >= 0 ? in[gidx] : nullptr;
        const int region = pm < 256 ? 0 : (pm < 260 ? 1 : 2);
        float gv[2][8];
#pragma unroll
        for (int bj = 0; bj < 2; ++bj)
#pragma unroll
            for (int i = 0; i < 8; ++i) gv[bj][i] = gain ? gain[32 * bj + 8 * fq + i] : 1.0f;
        size_t koffb = 0; int kpitch = 256, spb = 0, soff = 0, nh = 4, vp = 256, keep = 0; size_t obase = 0; int opitch = 256;
        if (mode != 0) {
            if (mixer == 0) { opitch = 128; kpitch = 128; nh = 2; keep = 128;
                if (region == 0) { koffb = mode == 1 ? WS_KAP : WS_VTAP; vp = 4096; obase = mode == 1 ? OFF_AKP : OFF_AVP; }
                else             { koffb = mode == 1 ? WS_KAS : WS_VTAS; vp = 192; spb = 192; soff = 128; obase = mode == 1 ? OFF_AKS : OFF_AVS; } }
            else if (mixer == 1) { keep = 512;
                if (region == 0) { koffb = mode == 1 ? WS_KBP : WS_VTBP; vp = 4096; obase = mode == 1 ? OFF_BKP : OFF_BVP; }
                else             { koffb = mode == 1 ? WS_KBS : WS_VTBS; vp = 576; spb = 576; soff = 512; obase = mode == 1 ? OFF_BKS : OFF_BVS; } }
            else { koffb = mode == 1 ? WS_MKP : WS_MVTP; vp = 256; obase = mode == 1 ? OFF_MKP : OFF_MVP; }
        }
        bf16* kbase = (bf16*)(ws + koffb);
#pragma unroll
        for (int ai = 0; ai < 2; ++ai)
#pragma unroll
            for (int m = 0; m < 4; ++m) {
                const int row = row0 + ai * 128 + m * 16; const float rs = rsv[ai][m];
                f32x2 v2[2][4];
#pragma unroll
                for (int bj = 0; bj < 2; ++bj)
#pragma unroll
                    for (int k = 0; k < 4; ++k) v2[bj][k] = (f32x2){acc[ai][bj][m][k >> 1][(k & 1) * 2], acc[ai][bj][m][k >> 1][(k & 1) * 2 + 1]} * rs;
                if (gain) {
                    f32x2 ss2 = (f32x2){0.f, 0.f};
#pragma unroll
                    for (int bj = 0; bj < 2; ++bj)
#pragma unroll
                        for (int k = 0; k < 4; ++k) ss2 += v2[bj][k] * v2[bj][k];
                    const float ss = fq_sum(ss2.x + ss2.y);
                    const float hs = rsqrtf(ss * (1.0f / 64.0f) + EPS) * (mode == 0 ? C2 : 1.0f);
#pragma unroll
                    for (int bj = 0; bj < 2; ++bj)
#pragma unroll
                        for (int k = 0; k < 4; ++k) v2[bj][k] *= (f32x2){gv[bj][2 * k], gv[bj][2 * k + 1]} * hs;
                }
                if (rope_on) {
                    const float posf = (float)(region == 0 ? (row & 4095) : 1024 + (row & 63));
#pragma unroll
                    for (int k = 0; k < 4; ++k) {
                        const f32x2 ir2 = (f32x2){__builtin_amdgcn_exp2f(-(float)(8 * fq + 2 * k) * 0.41524101186f), __builtin_amdgcn_exp2f(-(float)(8 * fq + 2 * k + 1) * 0.41524101186f)} * 0.15915494309f;
                        const f32x2 rv = ir2 * posf;
                        const float r0 = __builtin_amdgcn_fractf(rv.x), r1 = __builtin_amdgcn_fractf(rv.y);
                        const f32x2 c2 = (f32x2){__builtin_amdgcn_cosf(r0), __builtin_amdgcn_cosf(r1)}, s2 = (f32x2){__builtin_amdgcn_sinf(r0), __builtin_amdgcn_sinf(r1)};
                        const f32x2 lo2 = v2[0][k], hi2 = v2[1][k]; v2[0][k] = lo2 * c2 - hi2 * s2; v2[1][k] = lo2 * s2 + hi2 * c2; }
                }
                float v[2][8];
#pragma unroll
                for (int bj = 0; bj < 2; ++bj)
#pragma unroll
                    for (int k = 0; k < 4; ++k) { v[bj][2 * k] = v2[bj][k].x; v[bj][2 * k + 1] = v2[bj][k].y; }
                if (mode == 0) {
#pragma unroll
                    for (int bj = 0; bj < 2; ++bj) { u32x4 w; w.x = cvt_pk_bf16(v[bj][0], v[bj][1]); w.y = cvt_pk_bf16(v[bj][2], v[bj][3]);
                        w.z = cvt_pk_bf16(v[bj][4], v[bj][5]); w.w = cvt_pk_bf16(v[bj][6], v[bj][7]);
                        *(u32x4*)(Q + (size_t)row * D + qcol + 32 * bj + 8 * fq) = w; }
                } else {
                    int vb, tpos, orow;
                    if (region == 0) { const int pos = row & 4095, b = row >> 12; vb = b; tpos = pos; orow = pos >= 4096 - keep ? b * keep + pos - (4096 - keep) : -1; }
                    else if (region == 1) { const int sb = (row - MP) >> 6, t = row & 63; vb = sb; tpos = soff + t; orow = row - MP; }
                    else { vb = (row - M) >> 8; tpos = row & 255; orow = row - M; }
                    bf16* strm = kbase + (size_t)(vb * nh + hh) * vp * 64;
                    if (mode == 1) {
#pragma unroll
                        for (int bj = 0; bj < 2; ++bj) { u32x4 w; w.x = cvt_pk_bf16(v[bj][0], v[bj][1]); w.y = cvt_pk_bf16(v[bj][2], v[bj][3]);
                            w.z = cvt_pk_bf16(v[bj][4], v[bj][5]); w.w = cvt_pk_bf16(v[bj][6], v[bj][7]);
                            *(u32x4*)(strm + kf_off(tpos, 32 * bj + 8 * fq)) = w; }
                    } else {
#pragma unroll
                        for (int bj = 0; bj < 2; ++bj) { bf16* vt = strm + vf_off(tpos, 32 * bj + 8 * fq);
#pragma unroll
                            for (int i = 0; i < 8; i += 2) { const unsigned w = cvt_pk_bf16(v[bj][i], v[bj][i + 1]);
                                vt[i * 8] = (bf16)(w & 0xffffu); vt[(i + 1) * 8] = (bf16)(w >> 16); } }
                    }
                    if (orow >= 0) { float* op = out + obase + (size_t)orow * opitch + hh * 64 + 8 * fq;
#pragma unroll
                        for (int bj = 0; bj < 2; ++bj) { *(f32x4*)(op + 32 * bj) = (f32x4){v[bj][0], v[bj][1], v[bj][2], v[bj][3]}; *(f32x4*)(op + 32 * bj + 4) = (f32x4){v[bj][4], v[bj][5], v[bj][6], v[bj][7]}; }
                    }
                }
            }
    }
};
struct EpiBr {
    static constexpr bool PERM = true, AFTER_DRAIN = false, HOOK = true, RSLDS = false;
    typedef NoRs RsT;
    unsigned char* ws;
    __device__ __forceinline__ void hook(f32x4 (&acc)[2][2][4][2], const Unit& u, int t, int wr, int wc, int fr, int fq) const {
        const int num = (t == 8) ? 0 : 1;
        int tidg = (wr * 4 + wc) * 64 + fq * 16 + fr;
        asm volatile("" : "+v"(tidg));
        const unsigned char* G = ws + WS_H;
        u32x2 a[2][4][2], b[2][4][2];
#pragma unroll
        for (int ai = 0; ai < 2; ++ai)
#pragma unroll
            for (int m = 0; m < 4; ++m)
#pragma unroll
                for (int bj = 0; bj < 2; ++bj) { a[ai][m][bj] = *(const u32x2*)(G + gate_off8(u.pm, num * 4 + u.pn, ai, m, bj, tidg)); b[ai][m][bj] = *(const u32x2*)(G + gate_off8(u.pm, num * 4 + 4 + u.pn, ai, m, bj, tidg)); }
#pragma unroll
        for (int ai = 0; ai < 2; ++ai)
#pragma unroll
            for (int m = 0; m < 4; ++m)
#pragma unroll
                for (int bj = 0; bj < 2; ++bj)
#pragma unroll
                    for (int i = 0; i < 8; i += 2) { const unsigned wa = i < 4 ? a[ai][m][bj].x : a[ai][m][bj].y, wb = i < 4 ? b[ai][m][bj].x : b[ai][m][bj].y;
                        const f32x2 rb = (f32x2){__builtin_amdgcn_rcpf(ub(wb, i & 3)), __builtin_amdgcn_rcpf(ub(wb, (i + 1) & 3))};
                        const f32x2 r2 = (f32x2){ub(wa, i & 3), ub(wa, (i + 1) & 3)} * rb;
                        const f32x2 v2 = (f32x2){acc[ai][bj][m][i >> 2][i & 3], acc[ai][bj][m][i >> 2][(i & 3) + 1]} * r2;
                        acc[ai][bj][m][i >> 2][i & 3] = v2.x; acc[ai][bj][m][i >> 2][(i & 3) + 1] = v2.y; }
    }
    __device__ __forceinline__ void operator()(const f32x4 (&acc)[2][2][4][2], const Unit& u, int wr, int wc, int fr, int fq) const {
        const unsigned char* G = ws + WS_H; bf16* outp = (bf16*)(ws + WS_Q);
        const int row0 = u.pm * 256 + wr * 64 + fr, col0 = u.pn * 256 + wc * 32 + 8 * fq, tidg = (wr * 4 + wc) * 64 + fq * 16 + fr;
        u32x2 a[2][4][2];
#pragma unroll
        for (int ai = 0; ai < 2; ++ai)
#pragma unroll
            for (int m = 0; m < 4; ++m)
#pragma unroll
                for (int bj = 0; bj < 2; ++bj) a[ai][m][bj] = *(const u32x2*)(G + gate_off8(u.pm, 8 + u.pn, ai, m, bj, tidg));
#pragma unroll
        for (int ai = 0; ai < 2; ++ai)
#pragma unroll
            for (int m = 0; m < 4; ++m) {
                const int row = row0 + ai * 128 + m * 16;
#pragma unroll
                for (int bj = 0; bj < 2; ++bj) { u32x4 w;
#pragma unroll
                    for (int j = 0; j < 4; ++j) { const unsigned wa = j < 2 ? a[ai][m][bj].x : a[ai][m][bj].y;
                        const f32x2 g2 = (f32x2){ub(wa, (2 * j) & 3), ub(wa, (2 * j + 1) & 3)} * (1.0f / 255.0f);
                        const f32x2 v2 = (f32x2){acc[ai][bj][m][j >> 1][(j & 1) * 2], acc[ai][bj][m][j >> 1][(j & 1) * 2 + 1]} * g2;
                        w[j] = cvt_pk_bf16(v2.x, v2.y); }
                    *(u32x4*)(outp + (size_t)row * D + col0 + bj * 128) = w; }
            }
    }
};
constexpr int NSLICE = 11, SLICE_NT = 4;
struct OrderSlice {
    int G, c;
    __device__ bool next(int i, Unit& u) const { const int L = i * G + c; if (L >= 16 * NSLICE) return false; const int tile = L & 15; u.ks = L >> 4; u.pm = 256 + (tile >> 2); u.pn = tile & 3; return true; }
    __device__ __forceinline__ void a_ready(const Unit&) const {}
    __device__ __forceinline__ void done(const Unit&) const {}
};
struct EpiPart {
    static constexpr bool PERM = true, AFTER_DRAIN = false, HOOK = false, RSLDS = false;
    typedef NoRs RsT;
    unsigned char* ws;
    __device__ __forceinline__ void operator()(const f32x4 (&acc)[2][2][4][2], const Unit& u, int wr, int wc, int fr, int fq) const {
        float* P = (float*)(ws + WS_PART) + (size_t)u.ks * (1024 * 1024);
        const int row0 = (u.pm - 256) * 256 + wr * 64 + fr, col0 = u.pn * 256 + wc * 32 + 8 * fq;
#pragma unroll
        for (int ai = 0; ai < 2; ++ai)
#pragma unroll
            for (int m = 0; m < 4; ++m)
#pragma unroll
                for (int bj = 0; bj < 2; ++bj) { float* p = P + (size_t)(row0 + ai * 128 + m * 16) * 1024 + col0 + bj * 128; *(f32x4*)p = acc[ai][bj][m][0]; *(f32x4*)(p + 4) = acc[ai][bj][m][1]; }
    }
};
__device__ __forceinline__ float sample_row_sum(const unsigned char* ws, int r, int lane, f32x4 (&xn)[4]) {
    const u32x2* xb = (const u32x2*)((const bf16*)(ws + WS_XB) + (size_t)(MP + r) * D); const float* P = (const float*)(ws + WS_PART) + (size_t)r * 1024;
    float ss = 0.f;
#pragma unroll
    for (int j = 0; j < 4; ++j) {
        const u32x2 o = xb[lane + 64 * j]; f32x4 p[NSLICE];
#pragma unroll
        for (int s_ = 0; s_ < NSLICE; ++s_) p[s_] = ((const f32x4*)(P + (size_t)s_ * (1024 * 1024)))[lane + 64 * j];
        f32x4 a = p[0];
#pragma unroll
        for (int s_ = 1; s_ < NSLICE; ++s_) a += p[s_];
        xn[j] = (f32x4){bf_lo(o.x), bf_hi(o.x), bf_lo(o.y), bf_hi(o.y)} + a * 0.5f;
        ss += (xn[j][0] * xn[j][0] + xn[j][1] * xn[j][1]) + (xn[j][2] * xn[j][2] + xn[j][3] * xn[j][3]);
    }
#pragma unroll
    for (int o_ = 1; o_ < 64; o_ <<= 1) ss += __shfl_xor(ss, o_);
    return ss;
}
struct OrderIn {
    pg8::StaticOrder base; int G, c;
    __device__ void init(int G_, int c_) { base.init(M, N_IN, G_, c_); G = G_; c = c_; }
    __device__ bool next(int i, Unit& u) const {
        const long L = (long)i * G + c; if (L < base.nwg) return base.next(i, u);
        const int r = (int)(L - base.nwg); if (r >= 32) return false;
        u.pm = 260 + (r >> 1); u.pn = 19 + (r & 1); u.ks = 0; return true;
    }
    __device__ __forceinline__ void a_ready(const Unit&) const {}
    __device__ __forceinline__ void done(const Unit&) const {}
};

__device__ __forceinline__ float max3f(float a, float b, float c) { float r; asm("v_max3_f32 %0, %1, %2, %3" : "=v"(r) : "v"(a), "v"(b), "v"(c)); return r; }
__device__ __forceinline__ int crow(int r, int hi) { return (r & 3) + 8 * (r >> 2) + 4 * hi; }
__device__ __forceinline__ void attn_task(const bf16* Qp, const bf16* Kp, const bf16* Vtp, int ntiles, bool has_sink, float sink2,
                                          bool has_bias, const LAS float* biasl, int j0, int qin, bf16* Yp, int lane) {
    const int r32 = lane & 31, hi = lane >> 5;
    bf16x8 qr[4];
#pragma unroll
    for (int d0 = 0; d0 < 4; ++d0) qr[d0] = *(const bf16x8*)(Qp + (size_t)r32 * D + d0 * 16 + hi * 8);
    f32x16 o0 = {}, o1 = {};
    float mrun = 0.f, lsum = 0.f;
    const bf16* kp = Kp + lane * 8;
    const bf16* vp = Vtp + lane * 8;
    bf16x8 kf[2][4], vf[2][4], kn[2][4], vn[2][4];
#define ATT_LOAD(KF, VF, IT) do { \
    _Pragma("unroll") for (int blk = 0; blk < 2; ++blk) _Pragma("unroll") for (int d0 = 0; d0 < 4; ++d0) KF[blk][d0] = *(const bf16x8*)(kp + ((2 * (IT) + blk) * 4 + d0) * 512); \
    _Pragma("unroll") for (int d0 = 0; d0 < 2; ++d0) _Pragma("unroll") for (int ks = 0; ks < 4; ++ks) VF[d0][ks] = *(const bf16x8*)(vp + ((2 * (IT) + d0) * 4 + ks) * 512); } while (0)
    ATT_LOAD(kf, vf, 0);
#pragma unroll 2
    for (int it = 0; it < ntiles; ++it) {
        if (it + 1 < ntiles) ATT_LOAD(kn, vn, it + 1);
        f32x16 p0 = {}, p1 = {};
#pragma unroll
        for (int d0 = 0; d0 < 4; ++d0) { p0 = __builtin_amdgcn_mfma_f32_32x32x16_bf16(kf[0][d0], qr[d0], p0, 0, 0, 0); p1 = __builtin_amdgcn_mfma_f32_32x32x16_bf16(kf[1][d0], qr[d0], p1, 0, 0, 0); }
        if (has_bias) {
            const int j = j0 - it;
            if (j >= 3) { const float bc = biasl[256];
#pragma unroll
                for (int r = 0; r < 16; ++r) { p0[r] += bc; p1[r] += bc; } }
            else { const int base = 64 * j + qin + r32 + 128 - 4 * hi;
#pragma unroll
                for (int r = 0; r < 16; ++r) { const int kvl = (r & 3) + 8 * (r >> 2); int i0 = base - kvl, i1 = base - kvl - 32; i0 = i0 > 256 ? 256 : i0; i1 = i1 > 256 ? 256 : i1;
                    p0[r] += biasl[i0]; p1[r] += biasl[i1]; } }
        }
        float mx;
        { float ma = max3f(p0[0], p0[1], p1[0]), mb = max3f(p0[2], p0[3], p1[1]); ma = max3f(ma, p1[2], p1[3]);
#pragma unroll
          for (int r = 4; r < 16; r += 4) { ma = max3f(ma, p0[r], p0[r + 1]); mb = max3f(mb, p0[r + 2], p0[r + 3]); ma = max3f(ma, p1[r], p1[r + 1]); mb = max3f(mb, p1[r + 2], p1[r + 3]); }
          mx = fmaxf(ma, mb); }
        { const auto rr = __builtin_amdgcn_permlane32_swap(__float_as_uint(mx), __float_as_uint(mx), false, false);
          mx = fmaxf(__uint_as_float(rr[0]), __uint_as_float(rr[1])) - mrun; }
        if (it == 0 || __any(mx > 8.0f)) {
            const float delta = it == 0 ? mx : fmaxf(mx, 0.f), alpha = __builtin_amdgcn_exp2f(-delta);
            mrun += delta; lsum *= alpha;
#pragma unroll
            for (int r = 0; r < 16; ++r) { o0[r] *= alpha; o1[r] *= alpha; }
        }
        f32x2 ps2 = (f32x2){0.f, 0.f};
#pragma unroll
        for (int r = 0; r < 16; r += 2) {
            const f32x2 a0 = (f32x2){p0[r], p0[r + 1]} - mrun, a1 = (f32x2){p1[r], p1[r + 1]} - mrun;
            p0[r] = __builtin_amdgcn_exp2f(a0.x); p0[r + 1] = __builtin_amdgcn_exp2f(a0.y); p1[r] = __builtin_amdgcn_exp2f(a1.x); p1[r + 1] = __builtin_amdgcn_exp2f(a1.y);
            ps2 += (f32x2){p0[r], p0[r + 1]} + (f32x2){p1[r], p1[r + 1]};
        }
        lsum += ps2.x + ps2.y;
        bf16x8 pk[4];
#pragma unroll
        for (int ks = 0; ks < 4; ++ks) { u32x4 w;
#pragma unroll
            for (int j = 0; j < 4; ++j) { const int r = 8 * (ks & 1) + 2 * j; w[j] = (ks < 2) ? cvt_pk_bf16(p0[r], p0[r + 1]) : cvt_pk_bf16(p1[r], p1[r + 1]); }
            pk[ks] = __builtin_bit_cast(bf16x8, w); }
#pragma unroll
        for (int ks = 0; ks < 4; ++ks) { o0 = __builtin_amdgcn_mfma_f32_32x32x16_bf16(vf[0][ks], pk[ks], o0, 0, 0, 0); o1 = __builtin_amdgcn_mfma_f32_32x32x16_bf16(vf[1][ks], pk[ks], o1, 0, 0, 0); }
#pragma unroll
        for (int a = 0; a < 2; ++a)
#pragma unroll
            for (int b = 0; b < 4; ++b) { kf[a][b] = kn[a][b]; vf[a][b] = vn[a][b]; }
    }
#undef ATT_LOAD
    float l; { const auto rr = __builtin_amdgcn_permlane32_swap(__float_as_uint(lsum), __float_as_uint(lsum), false, false); l = __uint_as_float(rr[0]) + __uint_as_float(rr[1]); }
    if (has_sink) l += __builtin_amdgcn_exp2f(sink2 - mrun);
    const float inv = 1.0f / l;
    bf16* yp = Yp + (size_t)r32 * D + 4 * hi;
#pragma unroll
    for (int rg = 0; rg < 4; ++rg) {
        u32x2 w0, w1; w0.x = cvt_pk_bf16(o0[4 * rg] * inv, o0[4 * rg + 1] * inv); w0.y = cvt_pk_bf16(o0[4 * rg + 2] * inv, o0[4 * rg + 3] * inv);
        w1.x = cvt_pk_bf16(o1[4 * rg] * inv, o1[4 * rg + 1] * inv); w1.y = cvt_pk_bf16(o1[4 * rg + 2] * inv, o1[4 * rg + 3] * inv);
        *(u32x2*)(yp + 8 * rg) = w0; *(u32x2*)(yp + 32 + 8 * rg) = w1;
    }
}

#define XB_TMO      128
#define XB_XCNT(j)  (256  + 64 * (j))
#define XB_XSUB(j)  (1280 + 64 * (j))
#define XB_XGEN(j)  (2304 + 64 * (j))
#define XB_TOP      3328
#define XB_TOPGEN   3392
#define XCD_BAR_WORDS 3456
#define XB_SPIN_CAP (1u << 18)

__device__ __forceinline__ unsigned xb_ld(unsigned* p)              { return __hip_atomic_load(p, __ATOMIC_RELAXED, __HIP_MEMORY_SCOPE_AGENT); }
__device__ __forceinline__ unsigned xb_add(unsigned* p, unsigned v) { return __hip_atomic_fetch_add(p, v, __ATOMIC_RELAXED, __HIP_MEMORY_SCOPE_AGENT); }
__device__ __forceinline__ unsigned xb_xcc_id() { return (unsigned)__builtin_amdgcn_s_getreg((3 << 11) | 20) & 0xFu; }
#define XB_SPIN(cond, bar) do { unsigned _sp = 0; while (cond) { __builtin_amdgcn_s_sleep(1); \
    if ((++_sp & 255u) == 0u) { if (xb_ld(&(bar)[XB_TMO])) break; if (_sp > XB_SPIN_CAP) { atomicAdd(&(bar)[XB_TMO], 1u); break; } } } } while (0)

struct XcdBarrier {
    unsigned* bar; unsigned x; int w0;
    volatile LAS unsigned* st;
};

__device__ __forceinline__ XcdBarrier xcd_barrier_post(unsigned* bar, volatile LAS unsigned* st) {
    XcdBarrier b; b.bar = bar; b.x = xb_xcc_id(); b.st = st;
    if (threadIdx.x == 0) (void)xb_add(&bar[XB_XCNT(b.x)], 1u);
    return b;
}
__device__ __forceinline__ void xcd_barrier_complete(unsigned* bar, unsigned x, unsigned& nloc, unsigned& nx) {
    const unsigned G = gridDim.x * gridDim.y * gridDim.z;
    unsigned sum, cnt, mine, sp = 0u;
    for (;;) {
        sum = 0u; cnt = 0u; mine = 0u;
#pragma unroll
        for (unsigned j = 0; j < 16; ++j) { const unsigned c = xb_ld(&bar[XB_XCNT(j)]); sum += c; cnt += (c > 0u) ? 1u : 0u; mine = (j == x) ? c : mine; }
        if (sum == G) break;
        __builtin_amdgcn_s_sleep(1);
        if ((++sp & 255u) == 0u) { if (xb_ld(&bar[XB_TMO])) break; if (sp > XB_SPIN_CAP) { atomicAdd(&bar[XB_TMO], 1u); break; } }
    }
    nloc = mine > 0u ? mine : 1u; nx = cnt > 0u ? cnt : 1u;
}

__device__ __forceinline__ void xcd_barrier(const XcdBarrier& b) {
    asm volatile("s_waitcnt vmcnt(0)" ::: "memory");
    __syncthreads();
    if (b.w0 && lane_id() == 0) {
        unsigned* bar = b.bar;
        __builtin_amdgcn_s_waitcnt(0);
        unsigned nloc = b.st[0], nx = b.st[1];
        if (nloc == 0u) { xcd_barrier_complete(bar, b.x, nloc, nx); b.st[0] = nloc; b.st[1] = nx; }
        const unsigned old = xb_add(&bar[XB_XSUB(b.x)], 1u);
        const unsigned gen = old / nloc;
        if (old + 1u == (gen + 1u) * nloc) {
            __builtin_amdgcn_fence(__ATOMIC_RELEASE, "agent");
            asm volatile("s_waitcnt vmcnt(0)" ::: "memory");
            const unsigned og = xb_add(&bar[XB_TOP], 1u);
            const unsigned tg = og / nx;
            if (og + 1u == (tg + 1u) * nx) xb_add(&bar[XB_TOPGEN], 1u);
            else XB_SPIN(xb_ld(&bar[XB_TOPGEN]) == tg, bar);
            __builtin_amdgcn_fence(__ATOMIC_ACQUIRE, "agent");
            xb_add(&bar[XB_XGEN(b.x)], 1u);
            asm volatile("s_waitcnt vmcnt(0)" ::: "memory");
        } else {
            XB_SPIN(xb_ld(&bar[XB_XGEN(b.x)]) == gen, bar);
            __builtin_amdgcn_fence(__ATOMIC_ACQUIRE, "agent");
            asm volatile("s_waitcnt vmcnt(0)" ::: "memory");
        }
    }
    __syncthreads();
}

struct Args { const float* in[36]; float* out; unsigned char* ws; int ph_lo, ph_hi; };

__device__ __forceinline__ float wave_sum(float v) {
#pragma unroll
    for (int o = 1; o < 64; o <<= 1) v += __shfl_xor(v, o);
    return v;
}
__device__ __forceinline__ void tr_item(const float* W, int K, int N, const float* gain, bf16* WT, int pitch, int koff, int mapkind, int rowoff, LAS float* scr, int item, int lane) {
    const int nblk = N / 32, kb = item / nblk, nb = item % nblk, k0 = 64 * kb, n0 = 32 * nb;
#pragma unroll 8
    for (int i = 0; i < 32; ++i) { const int kk = 2 * i + (lane >> 5); float w = W[(size_t)(k0 + kk) * N + n0 + (lane & 31)]; if (gain) w *= gain[k0 + kk]; scr[kk * 33 + (lane & 31)] = w; }
    asm volatile("s_waitcnt lgkmcnt(0)" ::: "memory");
    int drow0;
    if (mapkind == 0) drow0 = n0;
    else if (mapkind == 1) drow0 = 256 * (n0 / 128) + (n0 % 128);
    else if (mapkind == 2) drow0 = 256 * (n0 / 128) + 128 + (n0 % 128);
    else { const int tile = n0 / 256, hh = (n0 % 256) / 64, dd = n0 % 64; drow0 = 256 * tile + 128 * (dd / 32) + 32 * hh; }
    drow0 += rowoff;
    const int c = lane & 7;
#pragma unroll
    for (int j = 0; j < 4; ++j) { const int n = (lane >> 3) + 8 * j; const LAS float* s = scr + (8 * c) * 33 + n;
        u32x4 o; o.x = cvt_pk_bf16(s[0 * 33], s[1 * 33]); o.y = cvt_pk_bf16(s[2 * 33], s[3 * 33]); o.z = cvt_pk_bf16(s[4 * 33], s[5 * 33]); o.w = cvt_pk_bf16(s[6 * 33], s[7 * 33]);
        *(u32x4*)(WT + (size_t)(drow0 + n) * pitch + koff + k0 + 8 * c) = o; }
    asm volatile("s_waitcnt lgkmcnt(0)" ::: "memory");
}
__device__ const double INVF[32] = {1.0, 0.7498942093324559, 0.5623413251903491, 0.4216965034285822, 0.31622776601683794, 0.23713737056616552, 0.1778279410038923, 0.1333521432163324,
    0.1, 0.07498942093324558, 0.05623413251903491, 0.042169650342858224, 0.03162277660168379, 0.023713737056616554, 0.01778279410038923, 0.01333521432163324,
    0.01, 0.007498942093324558, 0.005623413251903491, 0.004216965034285823, 0.0031622776601683794, 0.0023713737056616554, 0.0017782794100389228, 0.001333521432163324,
    0.001, 0.0007498942093324559, 0.0005623413251903491, 0.00042169650342858224, 0.00031622776601683794, 0.00023713737056616554, 0.00017782794100389227, 0.0001333521432163324};

__global__ void __launch_bounds__(NTHREADS, 2) mega(Args args) {
    extern __shared__ __attribute__((aligned(16))) unsigned char lds_raw[];
    LAS unsigned char* lds = (LAS unsigned char*)lds_raw;
    const int wave_s = __builtin_amdgcn_readfirstlane((int)threadIdx.x >> 6);
#define TIDS() int tid = wave_s * 64 + lane_id(); const int lane = tid & 63, wave = wave_s; (void)lane; (void)wave
    const int G = gridDim.x;
    int bx = blockIdx.x;
    int vcu = (G % 8 == 0) ? (bx % 8) * (G / 8) + bx / 8 : bx;
    float* out = args.out;
#define WSP(name) unsigned char* name = args.ws; asm volatile("" : "+s"(name))
#define PTR(T, base, off) ((T*)((base) + (off)))
    const float* const* in = args.in;
    const int lo = args.ph_lo, hi = args.ph_hi;
#define IN(k) (lo <= (k) && (k) < hi)
#if MK_MULTI
#define GRID_SYNC() do { } while (0)
#else
    cg::grid_group grid = cg::this_grid();
    volatile LAS unsigned* MISC = (volatile LAS unsigned*)(lds + RING_BYTES + 512);
    if (threadIdx.x == 0) { MISC[0] = 0u; MISC[1] = 0u; }
    __syncthreads();
    XcdBarrier xbar; xbar.bar = (unsigned*)args.ws; xbar.x = xb_xcc_id(); xbar.st = MISC; xbar.w0 = (wave_s == 0);
    if (threadIdx.x == 0) MISC[2] = xb_add(&xbar.bar[XB_XCNT(xbar.x)], 1u);
    __syncthreads();
#define GRID_SYNC() xcd_barrier(xbar)
#endif

#if PROBE_DUP == 10
    for (int rep0_ = 0; rep0_ < 2; ++rep0_)
#endif
    if (IN(0) && !SKIP_P0) {
        TIDS();
        WSP(w0);
        bf16 *WUP1 = PTR(bf16, w0, WS_WUP1), *WDN1 = PTR(bf16, w0, WS_WDN1), *WUP2 = PTR(bf16, w0, WS_WUP2), *WDN2 = PTR(bf16, w0, WS_WDN2), *WIN = PTR(bf16, w0, WS_WIN),
             *WBR = PTR(bf16, w0, WS_WBR), *WOUT = PTR(bf16, w0, WS_WOUT), *KAS = PTR(bf16, w0, WS_KAS), *VTAS = PTR(bf16, w0, WS_VTAS), *KBS = PTR(bf16, w0, WS_KBS),
             *VTBS = PTR(bf16, w0, WS_VTBS), *MKS = PTR(bf16, w0, WS_MKS), *MVTS = PTR(bf16, w0, WS_MVTS), *XB = PTR(bf16, w0, WS_XB);
        float* SSQ = PTR(float, w0, WS_SSQ); f32x2* ROPE = PTR(f32x2, w0, WS_ROPE);
        LAS float* scr = (LAS float*)(lds + wave * 16384);
        const int gw = vcu * NWAVES + wave, NGW = G * NWAVES;
        constexpr int I_UPH = 16 * 88, I_DN = 44 * 32, I_IN = 16 * 56, I_GT = 16 * 96, I_MEM = 16 * 16, I_BRA = 8 * 32, I_BRB = 4 * 32, I_OUT = 16 * 32;
        constexpr int NITEMS = 4 * I_UPH + 2 * I_DN + I_IN + I_GT + I_MEM + I_BRA + 2 * I_BRB + I_OUT;
        for (int it = gw; it < NITEMS; it += NGW) {
            int r = it;
            if (r < I_UPH) { tr_item(in[10], D, FF, in[9], WUP1, D, 0, 1, 0, scr, r, lane); continue; } r -= I_UPH;
            if (r < I_UPH) { tr_item(in[11], D, FF, in[9], WUP1, D, 0, 2, 0, scr, r, lane); continue; } r -= I_UPH;
            if (r < I_DN)  { tr_item(in[12], FF, D, nullptr, WDN1, FF, 0, 0, 0, scr, r, lane); continue; } r -= I_DN;
            if (r < I_UPH) { tr_item(in[32], D, FF, in[31], WUP2, D, 0, 1, 0, scr, r, lane); continue; } r -= I_UPH;
            if (r < I_UPH) { tr_item(in[33], D, FF, in[31], WUP2, D, 0, 2, 0, scr, r, lane); continue; } r -= I_UPH;
            if (r < I_DN)  { tr_item(in[34], FF, D, nullptr, WDN2, FF, 0, 0, 0, scr, r, lane); continue; } r -= I_DN;
            if (r < I_IN)  { tr_item(in[14], D, 1792, in[13], WIN, D, 0, 3, 0, scr, r, lane); continue; } r -= I_IN;
            if (r < I_GT)  { tr_item(in[25], D, 3072, in[13], WIN, D, 0, 0, 1792, scr, r, lane); continue; } r -= I_GT;
            if (r < I_MEM) { tr_item(in[23], D, 512, in[22], WIN, D, 0, 3, N_IN, scr, r, lane); continue; } r -= I_MEM;
            if (r < I_BRA) { tr_item(in[27], 512, D, nullptr, WBR, D, 0, 0, 0, scr, r, lane); continue; } r -= I_BRA;
            if (r < I_BRB) { tr_item(in[28], 256, D, nullptr, WBR, D, 512, 0, 0, scr, r, lane); continue; } r -= I_BRB;
            if (r < I_BRB) { tr_item(in[29], 256, D, nullptr, WBR, D, 768, 0, 0, scr, r, lane); continue; } r -= I_BRB;
            tr_item(in[30], D, D, nullptr, WOUT, D, 0, 0, 0, scr, r, lane);
        }
        for (int r = gw; r < MA; r += NGW) {
            const float* src = r < MP ? in[0] + (size_t)r * D : (r < M ? in[1] + (size_t)(r - MP) * D : in[8] + (size_t)(r - M) * D);
            f32x4 v[4]; float ss = 0.f;
#pragma unroll
            for (int j = 0; j < 4; ++j) { v[j] = ((const f32x4*)src)[lane + 64 * j]; ss += (v[j][0] * v[j][0] + v[j][1] * v[j][1]) + (v[j][2] * v[j][2] + v[j][3] * v[j][3]); }
            ss = wave_sum(ss);
            u32x2* o8 = (u32x2*)(XB + (size_t)r * D);
#pragma unroll
            for (int j = 0; j < 4; ++j) { u32x2 w; w.x = cvt_pk_bf16(v[j][0], v[j][1]); w.y = cvt_pk_bf16(v[j][2], v[j][3]); o8[lane + 64 * j] = w; }
            if (lane < 16) SSQ[(size_t)r * 16 + lane] = lane == 0 ? ss : 0.f;
        }
        const int gt = vcu * NTHREADS + tid, NTH = G * NTHREADS;
        for (int i = gt; i < 16 * 128 * 128; i += NTH) { const int sb = i >> 14, t = (i >> 7) & 127, c = i & 127;
            const size_t so = (size_t)(sb * 2 + (c >> 6)) * 192 * 64;
            KAS[so + kf_off(t, c & 63)] = (bf16)(cvt_pk_bf16(in[2][i], 0.f) & 0xffffu);
            VTAS[so + vf_off(t, c & 63)] = (bf16)(cvt_pk_bf16(in[3][i], 0.f) & 0xffffu); }
        for (int i = gt; i < 16 * 512 * 256; i += NTH) { const int sb = i >> 17, t = (i >> 8) & 511, c = i & 255;
            const size_t so = (size_t)(sb * 4 + (c >> 6)) * 576 * 64;
            KBS[so + kf_off(t, c & 63)] = (bf16)(cvt_pk_bf16(in[4][i], 0.f) & 0xffffu);
            VTBS[so + vf_off(t, c & 63)] = (bf16)(cvt_pk_bf16(in[5][i], 0.f) & 0xffffu); }
        for (int i = gt; i < 16 * 256 * 256; i += NTH) { const int sb = i >> 16, t = (i >> 8) & 255, c = i & 255;
            const size_t so = (size_t)(sb * 4 + (c >> 6)) * 256 * 64;
            MKS[so + kf_off(t, c & 63)] = (bf16)(cvt_pk_bf16(in[6][i], 0.f) & 0xffffu);
            MVTS[so + vf_off(t, c & 63)] = (bf16)(cvt_pk_bf16(in[7][i], 0.f) & 0xffffu); }
    }
#if MK_MULTI
    if (IN(0) && IN(1)) GRID_SYNC();
#else
    if (IN(0) && IN(1)) grid.sync();
    {
        unsigned* ctl = (unsigned*)args.ws; bool even = (G % 8 == 0);
        for (int j = 0; j < 8; ++j) even = even && (xb_ld(&ctl[XB_XCNT(j)]) == (unsigned)(G / 8));
        const int rk = (int)MISC[2], xc = (int)xbar.x;
        if (even && xc < 8 && rk < G / 8) { bx = rk * 8 + xc; vcu = xc * (G / 8) + rk; }
    }
#endif

#pragma unroll 1
    for (int pass = 0; pass < 2; ++pass) {
        const int ph = pass == 0 ? 1 : 7;
        if (IN(ph) && !SKIP_UP) {
            WSP(w1);
            pg8::Gemm g{PTR(bf16, w1, WS_XB), pass == 0 ? PTR(bf16, w1, WS_WUP1) : PTR(bf16, w1, WS_WUP2), M, N_UP, D, D / 64}; pg8::StaticOrder S; S.init(M, N_UP, G, bx);
            EpiUp E{w1};
            __syncthreads();
            pg8::gemm_phase<EpiUp, pg8::StaticOrder, PG8_ALIGN, PG8_SP2>(lds, g, S, E, wave_s);
#if PROBE_DUP == 1
            if (pass == 0) { __syncthreads(); pg8::gemm_phase<EpiUp, pg8::StaticOrder, PG8_ALIGN, PG8_SP2>(lds, g, S, E, wave_s); }
#endif
        }
        if (IN(ph) && IN(ph + 1)) GRID_SYNC();
        if (IN(ph + 1) && !SKIP_DN) {
            WSP(w2);
            pg8::Gemm g{PTR(bf16, w2, WS_H), pass == 0 ? PTR(bf16, w2, WS_WDN1) : PTR(bf16, w2, WS_WDN2), MP, D, FF, FF / 64}; pg8::StaticOrder S; S.init(MP, D, G, bx);
            EpiRes E{w2, 0.5f};
            __syncthreads();
            pg8::gemm_phase<EpiRes, pg8::StaticOrder, PG8_ALIGN, PG8_SP2>(lds, g, S, E, wave_s);
            pg8::Gemm g2{g.A, g.Bt, M, D, FF, SLICE_NT}; OrderSlice S2{G, bx}; EpiPart E2{w2};
            __syncthreads();
            pg8::gemm_phase<EpiPart, OrderSlice, PG8_ALIGN, PG8_SP2>(lds, g2, S2, E2, wave_s);
        }
        if (IN(ph + 1) && IN(ph + 2)) GRID_SYNC();
        if (pass == 1) break;
        if (IN(2)) {
            TIDS(); WSP(wf);
            const int gw = vcu * NWAVES + wave;
            if (gw < MSAMP) {
                f32x4 xn[4]; const float ss = sample_row_sum(wf, gw, lane, xn);
                u32x2* o8 = (u32x2*)(PTR(bf16, wf, WS_XB) + (size_t)(MP + gw) * D);
#pragma unroll
                for (int j = 0; j < 4; ++j) { u32x2 w; w.x = cvt_pk_bf16(xn[j][0], xn[j][1]); w.y = cvt_pk_bf16(xn[j][2], xn[j][3]); o8[lane + 64 * j] = w; }
                if (lane < 16) PTR(float, wf, WS_SSQ)[(size_t)(MP + gw) * 16 + lane] = lane == 0 ? ss : 0.f;
            }
        }
        if (IN(2) && IN(3)) GRID_SYNC();
        if (IN(3) && !SKIP_IN) {
            WSP(w3);
            pg8::Gemm g{PTR(bf16, w3, WS_XB), PTR(bf16, w3, WS_WIN), MA, N_INALL, D, D / 64}; OrderIn S; S.init(G, bx);
            EpiIn E{in, w3, out};
            __syncthreads();
            pg8::gemm_phase<EpiIn, OrderIn, PG8_ALIGN, PG8_SP2>(lds, g, S, E, wave_s);
#if PROBE_DUP == 3
            __syncthreads(); pg8::gemm_phase<EpiIn, OrderIn, PG8_ALIGN, PG8_SP2>(lds, g, S, E, wave_s);
#endif
        }
        if (IN(3) && IN(4)) GRID_SYNC();
        if (IN(4) && !SKIP_AT) {
            TIDS();
            WSP(w4);
            bf16 *KAS = PTR(bf16, w4, WS_KAS), *VTAS = PTR(bf16, w4, WS_VTAS), *KBS = PTR(bf16, w4, WS_KBS), *VTBS = PTR(bf16, w4, WS_VTBS), *MKS = PTR(bf16, w4, WS_MKS),
                 *MVTS = PTR(bf16, w4, WS_MVTS), *MKP = PTR(bf16, w4, WS_MKP), *MVTP = PTR(bf16, w4, WS_MVTP), *KAP = PTR(bf16, w4, WS_KAP), *VTAP = PTR(bf16, w4, WS_VTAP),
                 *KBP = PTR(bf16, w4, WS_KBP), *VTBP = PTR(bf16, w4, WS_VTBP), *QB = PTR(bf16, w4, WS_Q), *YB = PTR(bf16, w4, WS_Y);
            LAS float* biasl = (LAS float*)(lds + BIAS_OFF);
            for (int i = tid; i < 4 * 257; i += NTHREADS) biasl[i] = in[20][i] * LOG2E;
            __syncthreads();
            const int lane_o = lane;
            const int half = wave & 1, w2 = wave >> 1;
#if PROBE_DUP == 4
            for (int rep_ = 0; rep_ < 2; ++rep_)
#endif
            for (int ui_ = 0; ui_ < (G == 256 ? 19 : 4160); ++ui_) {
                int un;
                if (G == 256) {
                    const int v = vcu;
                    if (ui_ < 4) un = 256 * ui_ + (v & ~63) + ((v + 16 * ui_) & 63);
                    else if (ui_ == 4) un = v < 16 ? 1024 + v : -1;
                    else if (ui_ < 9) un = 1040 + v + 256 * (ui_ - 5);
                    else if (ui_ == 9) un = v >= 240 ? 2064 + (v - 240) : -1;
                    else { const int j = ui_ - 10, w = v - 16, n = v < 16 ? 5 : 8 + (w < 80 ? 1 : 0), st = v < 16 ? 5 * v : 80 + 8 * w + (w < 80 ? w : 80);
                        un = j < n ? 2080 + st + j : -1; }
                    if (un < 0) continue;
                } else { un = vcu + ui_ * G; if (un >= 4160) break; }
                if (un < 1040) {
                    const int bc = un, h = w2; const bf16 *Kp, *Vtp; int nt;
                    if (bc < 1024) { const int b = bc >> 6, c = bc & 63, cs = c > 8 ? c - 8 : 0; nt = c - cs + 1;
                        const size_t so = (size_t)(b * 4 + h) * 4096 * 64 + (size_t)cs * 4096; Kp = KBP + so; Vtp = VTBP + so; }
                    else { const int sb = bc - 1024; nt = 9; const size_t so = (size_t)(sb * 4 + h) * 576 * 64; Kp = KBS + so; Vtp = VTBS + so; }
                    attn_task(QB + (size_t)(bc * 64 + half * 32) * D + 512 + h * 64, Kp, Vtp, nt, false, 0.f, true, biasl + h * 257, nt - 1, half * 32,
                              YB + (size_t)(bc * 64 + half * 32) * D + 512 + h * 64, lane_o);
                } else if (un < 2080) {
                    const int bc = un - 1040, h = w2; const bf16 *Kp, *Vtp;
                    if (bc < 1024) { const int b = bc >> 6; const size_t so = (size_t)(b * 4 + h) * 256 * 64; Kp = MKP + so; Vtp = MVTP + so; }
                    else { const int sb = bc - 1024; const size_t so = (size_t)(sb * 4 + h) * 256 * 64; Kp = MKS + so; Vtp = MVTS + so; }
                    attn_task(QB + (size_t)(bc * 64 + half * 32) * D + 768 + h * 64, Kp, Vtp, 4, false, 0.f, false, biasl, 0, 0,
                              YB + (size_t)(bc * 64 + half * 32) * D + 768 + h * 64, lane_o);
                } else {
                    const int u2 = un - 2080, bc = u2 >> 1, kvh = u2 & 1, hq = 4 * kvh + w2; const bf16 *Kp, *Vtp; int nt;
                    if (bc < 1024) { const int b = bc >> 6, c = bc & 63, cs = c > 2 ? c - 2 : 0; nt = c - cs + 1;
                        const size_t so = (size_t)(b * 2 + kvh) * 4096 * 64 + (size_t)cs * 4096; Kp = KAP + so; Vtp = VTAP + so; }
                    else { const int sb = bc - 1024; nt = 3; const size_t so = (size_t)(sb * 2 + kvh) * 192 * 64; Kp = KAS + so; Vtp = VTAS + so; }
                    attn_task(QB + (size_t)(bc * 64 + half * 32) * D + hq * 64, Kp, Vtp, nt, true, in[17][hq] * LOG2E, false, biasl, 0, 0,
                              YB + (size_t)(bc * 64 + half * 32) * D + hq * 64, lane_o);
                }
            }
        }
        if (IN(4) && IN(5)) GRID_SYNC();
        if (IN(5) && !SKIP_BR) {
            WSP(w5);
            pg8::Gemm g{PTR(bf16, w5, WS_Y), PTR(bf16, w5, WS_WBR), M, D, D, D / 64}; pg8::StaticOrder S; S.init(M, D, G, bx);
            EpiBr E{w5};
            __syncthreads();
            pg8::gemm_phase<EpiBr, pg8::StaticOrder, PG8_ALIGN, PG8_SP2>(lds, g, S, E, wave_s);
#if PROBE_DUP == 5
            __syncthreads(); pg8::gemm_phase<EpiBr, pg8::StaticOrder, PG8_ALIGN, PG8_SP2>(lds, g, S, E, wave_s);
#endif
        }
        if (IN(5) && IN(6)) GRID_SYNC();
        if (IN(6) && !SKIP_OUT) {
            WSP(w6);
            pg8::Gemm g{PTR(bf16, w6, WS_Q), PTR(bf16, w6, WS_WOUT), M, D, D, D / 64}; pg8::StaticOrder S; S.init(M, D, G, bx);
            EpiRes E{w6, 1.0f};
            __syncthreads();
            pg8::gemm_phase<EpiRes, pg8::StaticOrder, PG8_ALIGN, PG8_SP2>(lds, g, S, E, wave_s);
        }
        if (IN(6) && IN(7)) GRID_SYNC();
    }
    if (IN(9)) {
        TIDS();
        const int gw = vcu * NWAVES + wave, NGW = G * NWAVES;
        WSP(w9); const float* SSQ9 = PTR(float, w9, WS_SSQ);
        const f32x4* gf = (const f32x4*)in[35];
        f32x4 gg[4];
#pragma unroll
        for (int j = 0; j < 4; ++j) gg[j] = gf[lane + 64 * j];
        const bf16* XB9 = PTR(bf16, w9, WS_XB);
        for (int r = gw * 4; r < MP; r += NGW * 4) {
            u32x2 v[4][4]; f32x4 pr[4];
#pragma unroll
            for (int k = 0; k < 4; ++k) { pr[k] = *(const f32x4*)(SSQ9 + (size_t)(r + k) * 16 + 4 * (lane & 3));
#pragma unroll
                for (int j = 0; j < 4; ++j) v[k][j] = ((const u32x2*)(XB9 + (size_t)(r + k) * D))[lane + 64 * j]; }
#pragma unroll
            for (int k = 0; k < 4; ++k) {
                float s_ = (pr[k][0] + pr[k][1]) + (pr[k][2] + pr[k][3]); s_ += __shfl_xor(s_, 1); s_ += __shfl_xor(s_, 2);
                const float rs = rsqrtf(s_ * (1.0f / 1024.0f) + EPS);
                f32x4* p = (f32x4*)(out + (size_t)(r + k) * D);
#pragma unroll
                for (int j = 0; j < 4; ++j) { const f32x4 x = (f32x4){bf_lo(v[k][j].x), bf_hi(v[k][j].x), bf_lo(v[k][j].y), bf_hi(v[k][j].y)}; p[lane + 64 * j] = x * rs * gg[j]; }
            }
        }
        if (gw < MSAMP) {
            f32x4 xn[4]; const float ss = sample_row_sum(w9, gw, lane, xn);
            const float rs = rsqrtf(ss * (1.0f / 1024.0f) + EPS);
            f32x4* p = (f32x4*)(out + (size_t)(MP + gw) * D);
#pragma unroll
            for (int j = 0; j < 4; ++j) p[lane + 64 * j] = xn[j] * rs * gg[j];
        }
    }
#undef IN
}

extern "C" void kernel_launch(void* const* d_in, const int* in_sizes, int n_in, void* d_out, int out_size, void* d_ws, size_t ws_size, hipStream_t stream) {
    static int grid = 0;
    if (grid == 0) {
        if (n_in != 36 || ws_size < WS_END) { fprintf(stderr, "kernel_launch: unexpected n_in %d / ws_size %zu (need %zu)\n", n_in, ws_size, (size_t)WS_END); grid = -1; return; }
        int dev = 0, cus = 0, per_cu = 0;
        (void)hipGetDevice(&dev); (void)hipDeviceGetAttribute(&cus, hipDeviceAttributeMultiprocessorCount, dev);
        (void)hipFuncSetAttribute((const void*)mega, hipFuncAttributeMaxDynamicSharedMemorySize, LDS_BYTES);
        if (hipOccupancyMaxActiveBlocksPerMultiprocessor(&per_cu, (const void*)mega, NTHREADS, LDS_BYTES) != hipSuccess || per_cu < 1) per_cu = 1;
        (void)hipGetLastError();
        if (per_cu > 1) per_cu = 1;
        grid = cus * per_cu; if (grid <= 0) grid = 256;
    }
    if (grid < 0) return;
    Args a{};
    for (int i = 0; i < 36; ++i) a.in[i] = (const float*)d_in[i];
    a.out = (float*)d_out; a.ws = (unsigned char*)d_ws;
#if MK_MULTI
    for (int p = 0; p < 10; ++p) { a.ph_lo = p; a.ph_hi = p + 1; hipLaunchKernelGGL(mega, dim3(grid), dim3(NTHREADS), LDS_BYTES, stream, a); }
#else
    a.ph_lo = 0; a.ph_hi = 10;
    (void)hipMemsetAsync(d_ws, 0, 16384, stream);
    void* kargs[] = {&a};
    hipError_t e = hipLaunchCooperativeKernel((const void*)mega, dim3(grid), dim3(NTHREADS), kargs, LDS_BYTES, stream);
    if (e != hipSuccess) fprintf(stderr, "cooperative launch failed: %s (grid %d)\n", hipGetErrorString(e), grid);
#endif
}
```

```cpp
#include <hip/hip_runtime.h>
#include <hip/hip_cooperative_groups.h>
#include <cstdio>
#include <cstdint>
namespace cg = cooperative_groups;
__device__ __forceinline__ int lane_id() { int l; asm volatile("v_mbcnt_lo_u32_b32 %0, -1, 0\n\tv_mbcnt_hi_u32_b32 %0, -1, %0" : "=v"(l)); return l; }
namespace pg8 {
#define PG8_LAS __attribute__((address_space(3)))
typedef unsigned short bf16_t;
typedef short bf16x8 __attribute__((ext_vector_type(8)));
typedef float f32x4 __attribute__((ext_vector_type(4)));
typedef unsigned u32x4 __attribute__((ext_vector_type(4)));
constexpr int BM = 256, BK = 64, HALF = 128, HTB = HALF * BK * 2  , STAGE_BYTES = 8 * HTB, NXCD = 8, WGM = 8;

__host__ __device__ __forceinline__ int lds_byte(int r, int c) { const int st = (r >> 4) * 2 + (c >> 5), rr = r & 15, cc = c & 31, ob = rr * 64 + cc * 2; return st * 1024 + (ob ^ (((ob >> 9) & 1) << 5)); }
__host__ __device__ __forceinline__ void stage_rc(int b, int& R, int& C) { const int st = b / 1024, sb = b % 1024, swz = sb ^ (((sb >> 9) & 1) << 5); R = (st >> 1) * 16 + swz / 64; C = (st & 1) * 32 + (swz % 64) / 2; }
__host__ __device__ __forceinline__ int perm32(int rho) { const int n = rho >> 4, i = rho & 15; return 8 * (i >> 2) + 4 * n + (i & 3); }

struct Unit { int pm, pn, ks; };
struct Gemm { const bf16_t* A; const bf16_t* Bt; int M, N, K, nt; };

struct StaticOrder {
    int nM, nN, nwg, G, c;
    __host__ __device__ void init(int M, int N, int G_, int c_) { nM = M / BM; nN = N / BM; nwg = nM * nN; G = G_; c = c_; }
    __host__ __device__ bool next(int i, Unit& u) const {
        const long L = (long)i * G + c; if (L >= nwg) return false;
        int wgid = (int)L; { const int q = nwg / NXCD, r = nwg % NXCD, xcd = wgid % NXCD, off = wgid / NXCD; wgid = (xcd < r ? xcd * (q + 1) : r * (q + 1) + (xcd - r) * q) + off; }
        const int nig = WGM * nN, gid = wgid / nig, fm = gid * WGM, gsz = (nM - fm) < WGM ? (nM - fm) : WGM;
        u.pm = fm + ((wgid % nig) % gsz); u.pn = (wgid % nig) / gsz; u.ks = 0; return true;
    }
    __device__ __forceinline__ void a_ready(const Unit&) const {}
    __device__ __forceinline__ void done(const Unit&) const {}
};

typedef float cvt_f32x2_t __attribute__((ext_vector_type(2))); typedef __bf16 cvt_bf16x2_t __attribute__((ext_vector_type(2)));
__device__ __forceinline__ unsigned cvt_pk_bf16(float lo, float hi) { const cvt_f32x2_t v = {lo, hi}; const cvt_bf16x2_t b = __builtin_convertvector(v, cvt_bf16x2_t); return __builtin_bit_cast(unsigned, b); }
template <class Epi, class Sched, bool ALIGN_EPI = false, bool SP2 = false>
__device__ __forceinline__ void gemm_phase(PG8_LAS unsigned char* lds, const Gemm g, const Sched& S, const Epi& E, int wave_s) {
    int tid_o = wave_s * 64 + lane_id(); asm volatile("" : "+v"(tid_o));
    const int tid = tid_o, wid = __builtin_amdgcn_readfirstlane(tid >> 6), lane = tid & 63, wr = wid >> 2, wc = wid & 3, fr = lane & 15, fq = lane >> 4;
    const int K = g.K, nt = g.nt;
    unsigned voffA[2], voffB[2];
#pragma unroll
    for (int i = 0; i < 2; ++i) { int R, C; stage_rc(tid * 16 + i * 8192, R, C); const int Rb = Epi::PERM ? ((R & ~31) + perm32(R & 31)) : R;
        voffA[i] = (unsigned)(R * K + C) * 2u; voffB[i] = (unsigned)(Rb * K + C) * 2u; }
    const size_t kstep = (size_t)(BK * 2);
    const size_t hstep = (size_t)HALF * K * 2;
    const size_t tstep = 2 * hstep;
    const unsigned ldsw = (unsigned)wid * 1024u;
    const int aoff = lds_byte(wr * 64 + fr, fq * 8), boff = lds_byte(wc * 32 + fr, fq * 8);
#define PG8_SA(b, h) (((b) * 2 + (h)) * HTB)
#define PG8_SB(b, h) ((4 + (b) * 2 + (h)) * HTB)
#define PG8_STAGE(bufoff, gbase, voff) do { _Pragma("unroll") for (int _i = 0; _i < 2; ++_i) \
        __builtin_amdgcn_global_load_lds((const unsigned*)((const char*)(gbase) + (voff)[_i]), (PG8_LAS unsigned*)(lds + (bufoff) + ldsw + _i * 8192), 16, 0, 0); } while (0)
#define PG8_LDA(dst, b, h) do { _Pragma("unroll") for (int m = 0; m < 4; ++m) _Pragma("unroll") for (int k = 0; k < 2; ++k) dst[m][k] = *(const PG8_LAS bf16x8*)(lds + PG8_SA(b, h) + aoff + m * 2048 + k * 1024); } while (0)
#define PG8_LDB(dst, b, h) do { _Pragma("unroll") for (int n = 0; n < 2; ++n) _Pragma("unroll") for (int k = 0; k < 2; ++k) dst[n][k] = *(const PG8_LAS bf16x8*)(lds + PG8_SB(b, h) + boff + n * 2048 + k * 1024); } while (0)
#define PG8_MMA(ai, bj, At, Bt) do { __builtin_amdgcn_s_setprio(1); _Pragma("unroll") for (int m = 0; m < 4; ++m) _Pragma("unroll") for (int n = 0; n < 2; ++n) _Pragma("unroll") for (int k = 0; k < 2; ++k) \
        acc[ai][bj][m][n] = __builtin_amdgcn_mfma_f32_16x16x32_bf16(Bt[n][k], At[m][k], acc[ai][bj][m][n], 0, 0, 0); __builtin_amdgcn_s_setprio(0); } while (0)
#define PG8_WAIT_V(n) asm volatile("s_waitcnt vmcnt(" #n ")" ::: "memory")
#define PG8_WAIT_L(n) asm volatile("s_waitcnt lgkmcnt(" #n ")" ::: "memory")
#define PG8_BAR __builtin_amdgcn_s_barrier()
#define PG8_SCHED __builtin_amdgcn_sched_barrier(0)
    Unit cur, nxt; int ui = 0;
    int rs_t = 2; asm volatile("" : "+s"(rs_t));
    if (!S.next(0, cur)) return;
    f32x4 acc[2][2][4][2];
#pragma unroll
    for (int a = 0; a < 2; ++a)
#pragma unroll
        for (int b = 0; b < 2; ++b)
#pragma unroll
            for (int m = 0; m < 4; ++m)
#pragma unroll
                for (int n = 0; n < 2; ++n) acc[a][b][m][n] = (f32x4){0.f, 0.f, 0.f, 0.f};
    bf16x8 At[4][2], B0[2][2], B1[2][2];
    const size_t sstep = (size_t)nt * kstep;
    const char* cA = (const char*)g.A + (size_t)cur.pm * tstep + (size_t)cur.ks * sstep; const char* cB = (const char*)g.Bt + (size_t)cur.pn * tstep + (size_t)cur.ks * sstep;
    S.a_ready(cur);
    if constexpr (SP2) {
        PG8_STAGE(PG8_SB(0, 0), cB, voffB); PG8_STAGE(PG8_SB(0, 1), cB + hstep, voffB); PG8_STAGE(PG8_SA(0, 0), cA, voffA); PG8_STAGE(PG8_SA(0, 1), cA + hstep, voffA);
        if (wr == 1) PG8_BAR;
        PG8_WAIT_V(2); PG8_BAR;
        PG8_STAGE(PG8_SB(1, 0), cB + kstep, voffB); PG8_STAGE(PG8_SA(1, 0), cA + kstep, voffA); PG8_STAGE(PG8_SB(1, 1), cB + hstep + kstep, voffB);
        PG8_WAIT_V(6); PG8_BAR;
    } else {
        PG8_STAGE(PG8_SB(0, 0), cB, voffB); PG8_STAGE(PG8_SA(0, 0), cA, voffA); PG8_STAGE(PG8_SB(0, 1), cB + hstep, voffB); PG8_STAGE(PG8_SA(0, 1), cA + hstep, voffA);
        if (wr == 1) PG8_BAR;
        PG8_WAIT_V(4); PG8_BAR;
        PG8_STAGE(PG8_SB(1, 0), cB + kstep, voffB); PG8_STAGE(PG8_SA(1, 0), cA + kstep, voffA); PG8_STAGE(PG8_SB(1, 1), cB + hstep + kstep, voffB);
        PG8_WAIT_V(6); PG8_BAR;
    }
    for (;;) {
        const bool has_next = S.next(ui + 1, nxt);
        const char* nA = has_next ? (const char*)g.A + (size_t)nxt.pm * tstep + (size_t)nxt.ks * sstep : cA; const char* nB = has_next ? (const char*)g.Bt + (size_t)nxt.pn * tstep + (size_t)nxt.ks * sstep : cB;
        for (int t = 0; t < nt; t += 2) {
            if constexpr (Epi::HOOK) { if (t == 8 || t == 12) E.hook(acc, cur, t, wr, wc, fr, fq); }
            typename Epi::RsT rsr;
            if constexpr (Epi::RSLDS) { if (t == rs_t) E.rs_issue(cur, wid, lane, rsr); }
            const bool last = (t == nt - 2);
            const char* a1 = cA + (size_t)(t + 1) * kstep;
            const char* a2 = last ? nA : cA + (size_t)(t + 2) * kstep; const char* b2 = last ? nB : cB + (size_t)(t + 2) * kstep;
            const char* a3 = a2 + kstep; const char* b3 = b2 + kstep;
            if (last && has_next) S.a_ready(nxt);
            if constexpr (SP2) {
            PG8_LDB(B0, 0, 0); PG8_LDB(B1, 0, 1); PG8_SCHED; PG8_LDA(At, 0, 0); PG8_STAGE(PG8_SA(1, 1), a1 + hstep, voffA);
            PG8_WAIT_V(8); PG8_WAIT_L(0); PG8_BAR; PG8_MMA(0, 0, At, B0); PG8_MMA(0, 1, At, B1); PG8_BAR; PG8_SCHED;
            PG8_LDA(At, 0, 1); PG8_STAGE(PG8_SB(0, 0), b2, voffB); PG8_STAGE(PG8_SB(0, 1), b2 + hstep, voffB); PG8_STAGE(PG8_SA(0, 0), a2, voffA);
            PG8_WAIT_V(8); PG8_WAIT_L(0); PG8_BAR; PG8_MMA(1, 0, At, B0); PG8_MMA(1, 1, At, B1); PG8_BAR; PG8_SCHED;
            PG8_LDB(B0, 1, 0); PG8_LDB(B1, 1, 1); PG8_SCHED; PG8_LDA(At, 1, 0); PG8_STAGE(PG8_SA(0, 1), a2 + hstep, voffA);
            PG8_WAIT_V(8); PG8_WAIT_L(0); PG8_BAR; PG8_MMA(0, 0, At, B0); PG8_MMA(0, 1, At, B1); PG8_BAR; PG8_SCHED;
            PG8_LDA(At, 1, 1); PG8_STAGE(PG8_SB(1, 0), b3, voffB); PG8_STAGE(PG8_SB(1, 1), b3 + hstep, voffB); PG8_STAGE(PG8_SA(1, 0), a3, voffA);
            PG8_WAIT_V(8); PG8_WAIT_L(0); PG8_BAR; PG8_MMA(1, 0, At, B0); PG8_MMA(1, 1, At, B1); PG8_BAR; PG8_SCHED;
            } else {
            PG8_LDB(B0, 0, 0); PG8_SCHED; PG8_LDA(At, 0, 0); PG8_STAGE(PG8_SA(1, 1), a1 + hstep, voffA);
            PG8_WAIT_L(8); PG8_BAR; PG8_WAIT_L(0); PG8_MMA(0, 0, At, B0); PG8_BAR; PG8_SCHED;
            PG8_LDB(B1, 0, 1); PG8_STAGE(PG8_SB(0, 0), b2, voffB);
            PG8_BAR; PG8_WAIT_L(0); PG8_MMA(0, 1, At, B1); PG8_BAR;
            PG8_LDA(At, 0, 1); PG8_STAGE(PG8_SA(0, 0), a2, voffA);
            PG8_BAR; PG8_WAIT_L(0); PG8_MMA(1, 0, At, B0); PG8_BAR; PG8_SCHED;
            PG8_STAGE(PG8_SB(0, 1), b2 + hstep, voffB);
            PG8_WAIT_V(6); PG8_BAR; PG8_MMA(1, 1, At, B1); PG8_BAR;
            PG8_LDB(B0, 1, 0); PG8_SCHED; PG8_LDA(At, 1, 0); PG8_STAGE(PG8_SA(0, 1), a2 + hstep, voffA);
            PG8_WAIT_L(8); PG8_BAR; PG8_WAIT_L(0); PG8_MMA(0, 0, At, B0); PG8_BAR; PG8_SCHED;
            PG8_LDB(B1, 1, 1); PG8_STAGE(PG8_SB(1, 0), b3, voffB);
            PG8_BAR; PG8_WAIT_L(0); PG8_MMA(0, 1, At, B1); PG8_BAR;
            PG8_LDA(At, 1, 1); PG8_STAGE(PG8_SA(1, 0), a3, voffA);
            PG8_BAR; PG8_WAIT_L(0); PG8_MMA(1, 0, At, B0); PG8_BAR; PG8_SCHED;
            PG8_STAGE(PG8_SB(1, 1), b3 + hstep, voffB);
            PG8_WAIT_V(6); PG8_BAR; PG8_MMA(1, 1, At, B1); PG8_BAR;
            }
            if constexpr (Epi::RSLDS) { if (t == rs_t) E.rs_finish(lds, wid, lane, rsr); }
        }
        if constexpr (ALIGN_EPI) { if (wr == 0) PG8_BAR; }
        if constexpr (!Epi::AFTER_DRAIN) { E(acc, cur, wr, wc, fr, fq); S.done(cur); }
        if (!has_next) break;
#pragma unroll
        for (int a = 0; a < 2; ++a)
#pragma unroll
            for (int b = 0; b < 2; ++b)
#pragma unroll
                for (int m = 0; m < 4; ++m)
#pragma unroll
                    for (int n = 0; n < 2; ++n) acc[a][b][m][n] = (f32x4){0.f, 0.f, 0.f, 0.f};
        cur = nxt; cA = nA; cB = nB; ++ui;
        if constexpr (ALIGN_EPI) { if (wr == 1) PG8_BAR; }
    }
    PG8_WAIT_V(0);
    if constexpr (!ALIGN_EPI) { if (wr == 0) PG8_BAR; }
    PG8_BAR;
    if constexpr (Epi::AFTER_DRAIN) { E.fused(acc, cur, wr, wc, fr, fq, lds, wid, lane); S.done(cur); }
#undef PG8_SA
#undef PG8_SB
#undef PG8_STAGE
#undef PG8_LDA
#undef PG8_LDB
#undef PG8_MMA
#undef PG8_WAIT_V
#undef PG8_WAIT_L
#undef PG8_BAR
#undef PG8_SCHED
}
}
#ifndef PG8_SP2
#define PG8_SP2 true
#endif
#ifndef PG8_ALIGN
#define PG8_ALIGN true
#endif
#ifndef SKIP_UP
#define SKIP_UP 0
#endif
#ifndef SKIP_DN
#define SKIP_DN 0
#endif
#ifndef SKIP_IN
#define SKIP_IN 0
#endif
#ifndef SKIP_AT
#define SKIP_AT 0
#endif
#ifndef SKIP_BR
#define SKIP_BR 0
#endif
#ifndef SKIP_OUT
#define SKIP_OUT 0
#endif
#ifndef SKIP_P0
#define SKIP_P0 0
#endif
#ifndef PROBE_DUP
#define PROBE_DUP 0
#endif
#ifndef MK_MULTI
#define MK_MULTI 0
#endif

#define LAS __attribute__((address_space(3)))
typedef unsigned short bf16;
typedef short bf16x8 __attribute__((ext_vector_type(8)));
typedef float f32x4 __attribute__((ext_vector_type(4)));
typedef float f32x2 __attribute__((ext_vector_type(2)));
typedef float f32x16 __attribute__((ext_vector_type(16)));
typedef unsigned u32x4 __attribute__((ext_vector_type(4)));
typedef unsigned u32x2 __attribute__((ext_vector_type(2)));

constexpr int D = 1024, FF = 2816, MP = 65536, MSAMP = 1024, M = MP + MSAMP, MMEM = 4096, MA = M + MMEM;
constexpr int N_UP = 2 * FF, N_IN = 4864, N_INALL = 5376;
constexpr float EPS = 1e-6f, LOG2E = 1.4426950408889634f, C2 = 0.125f * 1.4426950408889634f;
constexpr int NWAVES = 8, NTHREADS = 512;
constexpr int RING_BYTES = 131072, BIAS_OFF = RING_BYTES + 1024, LDS_BYTES = 147456;

constexpr size_t MiB = 1u << 20;
constexpr size_t WS_ROPE = 1 * MiB, WS_SSQ = 2 * MiB, WS_WUP1 = 8 * MiB, WS_WDN1 = 20 * MiB, WS_WUP2 = 26 * MiB, WS_WDN2 = 38 * MiB, WS_WIN = 44 * MiB,
                 WS_WBR = 56 * MiB, WS_WOUT = 58 * MiB, WS_KAS = 60 * MiB, WS_VTAS = 61 * MiB, WS_KBS = 62 * MiB, WS_VTBS = 67 * MiB, WS_MKS = 72 * MiB,
                 WS_MVTS = 74 * MiB, WS_MKP = 76 * MiB, WS_MVTP = 78 * MiB, WS_XB = 80 * MiB, WS_KAP = 218 * MiB, WS_VTAP = 234 * MiB, WS_KBP = 250 * MiB,
                 WS_VTBP = 282 * MiB, WS_Q = 314 * MiB, WS_Y = 444 * MiB, WS_H = 574 * MiB, WS_PART = 964 * MiB, WS_END = 1010 * MiB;
static_assert(WS_XB + (size_t)MA * D * 2 <= WS_KAP && WS_Q + (size_t)M * D * 2 <= WS_Y && WS_Y + (size_t)M * D * 2 <= WS_H && WS_H + (size_t)M * 3072 * 2 <= WS_PART && WS_PART + (size_t)11 * 1024 * 1024 * 4 <= WS_END, "ws map");
constexpr size_t OFF_AKP = 68157440, OFF_AVP = 68419584, OFF_BKP = 68681728, OFF_BVP = 70778880, OFF_MKP = 72876032, OFF_MVP = 73924608,
                 OFF_AKS = 74973184, OFF_AVS = 75104256, OFF_BKS = 75235328, OFF_BVS = 75497472;

using pg8::Unit;
using pg8::cvt_pk_bf16;

__device__ __forceinline__ float row_rs(const float* ssq, int row) {
    const f32x4* p = (const f32x4*)(ssq + (size_t)row * 16);
    const f32x4 a = p[0], b = p[1], c = p[2], d = p[3];
    const f32x4 s = (a + b) + (c + d);
    return rsqrtf(((s[0] + s[1]) + (s[2] + s[3])) * (1.0f / 1024.0f) + EPS);
}
__device__ __forceinline__ void load_rs8(const float* ssq, int row0, int fq, float (&rs)[2][4]) {
    f32x4 t[2][4];
#pragma unroll
    for (int ai = 0; ai < 2; ++ai)
#pragma unroll
        for (int m = 0; m < 4; ++m) t[ai][m] = *(const f32x4*)(ssq + (size_t)(row0 + ai * 128 + m * 16) * 16 + 4 * fq);
#pragma unroll
    for (int ai = 0; ai < 2; ++ai)
#pragma unroll
        for (int m = 0; m < 4; ++m) { float s_ = (t[ai][m][0] + t[ai][m][1]) + (t[ai][m][2] + t[ai][m][3]); s_ += __shfl_xor(s_, 16); s_ += __shfl_xor(s_, 32);
            rs[ai][m] = rsqrtf(s_ * (1.0f / 1024.0f) + EPS); }
}
constexpr int RS_LDS_OFF = 131072 + 6144;
struct NoRs {};
struct RsReg { f32x4 a, b; };
__device__ __forceinline__ void rs_issue_regs(const float* ssq, int pm, int wid, int lane, RsReg& r) {
    const f32x4* p = (const f32x4*)(ssq + (size_t)(pm * 256 + 32 * wid + (lane >> 1)) * 16 + 8 * (lane & 1)); r.a = p[0]; r.b = p[1];
}
__device__ __forceinline__ void rs_finish_lds(__attribute__((address_space(3))) unsigned char* lds, int wid, int lane, const RsReg& r) {
    float s_ = ((r.a[0] + r.a[1]) + (r.a[2] + r.a[3])) + ((r.b[0] + r.b[1]) + (r.b[2] + r.b[3])); s_ += __shfl_xor(s_, 1);
    if (!(lane & 1)) ((__attribute__((address_space(3))) float*)(lds + RS_LDS_OFF))[32 * wid + (lane >> 1)] = rsqrtf(s_ * (1.0f / 1024.0f) + EPS);
}
__device__ __forceinline__ void rs_fill_lds(const float* ssq, int pm, __attribute__((address_space(3))) unsigned char* lds, int wid, int lane) {
    const int r = 32 * wid + (lane >> 1);
    const f32x4* p = (const f32x4*)(ssq + (size_t)(pm * 256 + r) * 16 + 8 * (lane & 1));
    const f32x4 a = p[0], b = p[1];
    float s_ = ((a[0] + a[1]) + (a[2] + a[3])) + ((b[0] + b[1]) + (b[2] + b[3])); s_ += __shfl_xor(s_, 1);
    if (!(lane & 1)) ((__attribute__((address_space(3))) float*)(lds + RS_LDS_OFF))[r] = rsqrtf(s_ * (1.0f / 1024.0f) + EPS);
}
__device__ __forceinline__ void rs_read_lds(int wr, int fr, float (&rs)[2][4]) {
    const __attribute__((address_space(3))) float* t = (const __attribute__((address_space(3))) float*)(uintptr_t)RS_LDS_OFF;
#pragma unroll
    for (int ai = 0; ai < 2; ++ai)
#pragma unroll
        for (int m = 0; m < 4; ++m) rs[ai][m] = t[ai * 128 + wr * 64 + m * 16 + fr];
}
__device__ __forceinline__ float fq_sum(float v) {
    const auto a = __builtin_amdgcn_permlane16_swap(__float_as_uint(v), __float_as_uint(v), false, false);
    const float s1 = __uint_as_float(a[0]) + __uint_as_float(a[1]);
    const auto b = __builtin_amdgcn_permlane32_swap(__float_as_uint(s1), __float_as_uint(s1), false, false);
    return __uint_as_float(b[0]) + __uint_as_float(b[1]);
}
__device__ __forceinline__ float bf_lo(unsigned w) { return __uint_as_float(w << 16); }
__device__ __forceinline__ float bf_hi(unsigned w) { return __uint_as_float(w & 0xffff0000u); }
__device__ __forceinline__ int kf_off(int t, int d) { return ((t >> 5) * 4 + (d >> 4)) * 512 + ((((d >> 3) & 1) * 32) + (t & 31)) * 8 + (d & 7); }
__device__ __forceinline__ int vf_off(int t, int d) { const int kvl = t & 15, hi = (kvl >> 2) & 1, e = ((kvl >> 3) << 2) | (kvl & 3);
    return (((t >> 6) * 2 + (d >> 5)) * 4 + ((t >> 4) & 3)) * 512 + (hi * 32 + (d & 31)) * 8 + e; }
__device__ __forceinline__ size_t gate_off8(int pm, int t, int ai, int m, int bj, int tid) { return ((((size_t)pm * 12 + t) * 16 + (ai * 4 + m) * 2 + bj) * 512 + tid) * 8; }
__device__ __forceinline__ float ub(unsigned w, int k) { return (float)((w >> (8 * k)) & 0xffu); }
__device__ __forceinline__ float sigm(float z) { return __builtin_amdgcn_rcpf(1.0f + __builtin_amdgcn_exp2f(-z * LOG2E)); }

struct EpiUp {
    static constexpr bool PERM = true, AFTER_DRAIN = false, HOOK = false, RSLDS = true;
    unsigned char* ws;
    typedef RsReg RsT;
    __device__ __forceinline__ void rs_issue(const Unit& u, int wid, int lane, RsReg& r) const { rs_issue_regs((const float*)(ws + WS_SSQ), u.pm, wid, lane, r); }
    __device__ __forceinline__ void rs_finish(__attribute__((address_space(3))) unsigned char* lds, int wid, int lane, const RsReg& r) const { rs_finish_lds(lds, wid, lane, r); }
    __device__ __forceinline__ void operator()(const f32x4 (&acc)[2][2][4][2], const Unit& u, int wr, int wc, int fr, int fq) const {
        const float* ssq = (const float*)(ws + WS_SSQ); bf16* H = (bf16*)(ws + WS_H);
        const int row0 = u.pm * 256 + wr * 64 + fr, col0 = u.pn * 128 + wc * 32 + 8 * fq;
        float rsv[2][4]; rs_read_lds(wr, fr, rsv); (void)ssq;
#pragma unroll
        for (int ai = 0; ai < 2; ++ai)
#pragma unroll
            for (int m = 0; m < 4; ++m) {
                const int row = row0 + ai * 128 + m * 16; const float rs = rsv[ai][m];
                const float k1 = -rs * LOG2E, k2 = rs * rs;
                float h[8];
#pragma unroll
                for (int n = 0; n < 2; ++n)
#pragma unroll
                    for (int e2 = 0; e2 < 2; ++e2) {
                        const f32x2 ag = (f32x2){acc[ai][0][m][n][2 * e2], acc[ai][0][m][n][2 * e2 + 1]}, au = (f32x2){acc[ai][1][m][n][2 * e2], acc[ai][1][m][n][2 * e2 + 1]};
                        const f32x2 ea = ag * k1; f32x2 ex; ex.x = __builtin_amdgcn_exp2f(ea.x); ex.y = __builtin_amdgcn_exp2f(ea.y);
                        const f32x2 den = ex + 1.0f; f32x2 sg; sg.x = __builtin_amdgcn_rcpf(den.x); sg.y = __builtin_amdgcn_rcpf(den.y);
                        const f32x2 hh = ((ag * au) * k2) * sg;
                        h[4 * n + 2 * e2] = hh.x; h[4 * n + 2 * e2 + 1] = hh.y; }
                u32x4 w; w.x = cvt_pk_bf16(h[0], h[1]); w.y = cvt_pk_bf16(h[2], h[3]); w.z = cvt_pk_bf16(h[4], h[5]); w.w = cvt_pk_bf16(h[6], h[7]);
                __builtin_nontemporal_store(w, (u32x4*)(H + (size_t)row * FF + col0));
            }
    }
};
struct EpiRes {
    static constexpr bool PERM = true, AFTER_DRAIN = false, HOOK = false, RSLDS = false;
    typedef NoRs RsT;
    unsigned char* ws; float scale;
    __device__ __forceinline__ void operator()(const f32x4 (&acc)[2][2][4][2], const Unit& u, int wr, int wc, int fr, int fq) const {
        bf16* xb = (bf16*)(ws + WS_XB); float* ssq = (float*)(ws + WS_SSQ);
        const int row0 = u.pm * 256 + wr * 64 + fr, col0 = u.pn * 256 + wc * 32 + 8 * fq;
        u32x4 old[2][4][2];
#pragma unroll
        for (int ai = 0; ai < 2; ++ai)
#pragma unroll
            for (int m = 0; m < 4; ++m)
#pragma unroll
                for (int bj = 0; bj < 2; ++bj) old[ai][m][bj] = *(const u32x4*)(xb + (size_t)(row0 + ai * 128 + m * 16) * D + col0 + bj * 128);
#pragma unroll
        for (int ai = 0; ai < 2; ++ai)
#pragma unroll
            for (int m = 0; m < 4; ++m) {
                const int row = row0 + ai * 128 + m * 16; f32x2 ss2 = (f32x2){0.f, 0.f};
#pragma unroll
                for (int bj = 0; bj < 2; ++bj) { const u32x4 o = old[ai][m][bj]; u32x4 w;
#pragma unroll
                    for (int j = 0; j < 4; ++j) {
                        const f32x2 a2 = (f32x2){acc[ai][bj][m][j >> 1][(j & 1) * 2], acc[ai][bj][m][j >> 1][(j & 1) * 2 + 1]};
                        const f32x2 n2 = a2 * scale + (f32x2){bf_lo(o[j]), bf_hi(o[j])};
                        ss2 += n2 * n2; w[j] = cvt_pk_bf16(n2.x, n2.y); }
                    *(u32x4*)(xb + (size_t)row * D + col0 + bj * 128) = w; }
                float ss = ss2.x + ss2.y;
                ss = fq_sum(ss);
                if (fq == 0) ssq[(size_t)row * 16 + u.pn * 4 + wc] = ss;
            }
    }
};
struct EpiIn {
    static constexpr bool PERM = true, AFTER_DRAIN = false, HOOK = false, RSLDS = true;
    const float* const* in; unsigned char* ws; float* out;
    typedef RsReg RsT;
    __device__ __forceinline__ void rs_issue(const Unit& u, int wid, int lane, RsReg& r) const { rs_issue_regs((const float*)(ws + WS_SSQ), u.pm, wid, lane, r); }
    __device__ __forceinline__ void rs_finish(__attribute__((address_space(3))) unsigned char* lds, int wid, int lane, const RsReg& r) const { rs_finish_lds(lds, wid, lane, r); }
    __device__ __forceinline__ void operator()(const f32x4 (&acc)[2][2][4][2], const Unit& u, int wr, int wc, int fr, int fq) const {
        const float* ssq = (const float*)(ws + WS_SSQ); const f32x2* rope = (const f32x2*)(ws + WS_ROPE);
        bf16* Q = (bf16*)(ws + WS_Q); bf16* G = (bf16*)(ws + WS_H);
        int pm_o = u.pm, pn_o = u.pn; asm volatile("" : "+s"(pm_o), "+s"(pn_o), "+s"(wc), "+s"(wr), "+v"(fr), "+v"(fq));
        const int pm = pm_o, pn = pn_o, row0 = pm * 256 + wr * 64 + fr;
        float rsv[2][4]; rs_read_lds(wr, fr, rsv); (void)ssq;
        if (pn >= 7 && pn < 19) {
            const int col0 = (pn - 7) * 256 + wc * 32 + 8 * fq;
            const float* b_gate = in[26];
            float bb[2][8];
#pragma unroll
            for (int bj = 0; bj < 2; ++bj)
#pragma unroll
                for (int i = 0; i < 8; ++i) bb[bj][i] = -LOG2E * b_gate[col0 + bj * 128 + i];
#pragma unroll
            for (int ai = 0; ai < 2; ++ai)
#pragma unroll
                for (int m = 0; m < 4; ++m) {
                    const int row = row0 + ai * 128 + m * 16; const float k1 = -LOG2E * rsv[ai][m];
#pragma unroll
                    for (int bj = 0; bj < 2; ++bj) { unsigned q[8];
#pragma unroll
                        for (int i2 = 0; i2 < 4; ++i2) {
                            const f32x2 a2 = (f32x2){acc[ai][bj][m][i2 >> 1][(i2 & 1) * 2], acc[ai][bj][m][i2 >> 1][(i2 & 1) * 2 + 1]};
                            const f32x2 ez = a2 * k1 + (f32x2){bb[bj][2 * i2], bb[bj][2 * i2 + 1]};
                            f32x2 ex; ex.x = __builtin_amdgcn_exp2f(ez.x); ex.y = __builtin_amdgcn_exp2f(ez.y);
                            const f32x2 den = ex + 1.0f; f32x2 sg; sg.x = __builtin_amdgcn_rcpf(den.x); sg.y = __builtin_amdgcn_rcpf(den.y);
                            const f32x2 qf = sg * 255.0f + 0.5f;
                            const unsigned q0 = (unsigned)qf.x, q1 = (unsigned)qf.y; q[2 * i2] = q0 < 1u ? 1u : q0; q[2 * i2 + 1] = q1 < 1u ? 1u : q1; }
                        u32x2 w; w.x = q[0] | (q[1] << 8) | (q[2] << 16) | (q[3] << 24); w.y = q[4] | (q[5] << 8) | (q[6] << 16) | (q[7] << 24);
                        __builtin_nontemporal_store(w, (u32x2*)((unsigned char*)G + gate_off8(pm, pn - 7, ai, m, bj, (wr * 4 + wc) * 64 + fq * 16 + fr))); (void)row; }
                }
            return;
        }
        int mode, mixer = 0, hh = wc, qcol = 0, gidx = -1; bool rope_on = false;
        if (pn <= 1)       { mode = 0; gidx = 15; rope_on = true; qcol = (4 * pn + wc) * 64; }
        else if (pn == 2)  { mixer = 0; if (wc < 2) { mode = 1; gidx = 16; rope_on = true; hh = wc; } else { mode = 2; hh = wc - 2; } }
        else if (pn == 3)  { mode = 0; gidx = 18; qcol = 512 + wc * 64; }
        else if (pn == 4)  { mode = 1; gidx = 19; mixer = 1; }
        else if (pn == 5)  { mode = 2; mixer = 1; }
        else if (pn == 6)  { mode = 0; gidx = 21; qcol = 768 + wc * 64; }
        else if (pn == 19) { mode = 1; gidx = 24; mixer = 2; }
        else               { mode = 2; mixer = 2; }
        const float* gain = gidx >= 0 ? in[gidx] : nullptr;
        const int region = pm < 256 ? 0 : (pm < 260 ? 1 : 2);
        float gv[2][8];
#pragma unroll
        for (int bj = 0; bj < 2; ++bj)
#pragma unroll
            for (int i = 0; i < 8; ++i) gv[bj][i] = gain ? gain[32 * bj + 8 * fq + i] : 1.0f;
        size_t koffb = 0; int kpitch = 256, spb = 0, soff = 0, nh = 4, vp = 256, keep = 0; size_t obase = 0; int opitch = 256;
        if (mode != 0) {
            if (mixer == 0) { opitch = 128; kpitch = 128; nh = 2; keep = 128;
                if (region == 0) { koffb = mode == 1 ? WS_KAP : WS_VTAP; vp = 4096; obase = mode == 1 ? OFF_AKP : OFF_AVP; }
                else             { koffb = mode == 1 ? WS_KAS : WS_VTAS; vp = 192; spb = 192; soff = 128; obase = mode == 1 ? OFF_AKS : OFF_AVS; } }
            else if (mixer == 1) { keep = 512;
                if (region == 0) { koffb = mode == 1 ? WS_KBP : WS_VTBP; vp = 4096; obase = mode == 1 ? OFF_BKP : OFF_BVP; }
                else             { koffb = mode == 1 ? WS_KBS : WS_VTBS; vp = 576; spb = 576; soff = 512; obase = mode == 1 ? OFF_BKS : OFF_BVS; } }
            else { koffb = mode == 1 ? WS_MKP : WS_MVTP; vp = 256; obase = mode == 1 ? OFF_MKP : OFF_MVP; }
        }
        bf16* kbase = (bf16*)(ws + koffb);
#pragma unroll
        for (int ai = 0; ai < 2; ++ai)
#pragma unroll
            for (int m = 0; m < 4; ++m) {
                const int row = row0 + ai * 128 + m * 16; const float rs = rsv[ai][m];
                f32x2 v2[2][4];
#pragma unroll
                for (int bj = 0; bj < 2; ++bj)
#pragma unroll
                    for (int k = 0; k < 4; ++k) v2[bj][k] = (f32x2){acc[ai][bj][m][k >> 1][(k & 1) * 2], acc[ai][bj][m][k >> 1][(k & 1) * 2 + 1]} * rs;
                if (gain) {
                    f32x2 ss2 = (f32x2){0.f, 0.f};
#pragma unroll
                    for (int bj = 0; bj < 2; ++bj)
#pragma unroll
                        for (int k = 0; k < 4; ++k) ss2 += v2[bj][k] * v2[bj][k];
                    const float ss = fq_sum(ss2.x + ss2.y);
                    const float hs = rsqrtf(ss * (1.0f / 64.0f) + EPS) * (mode == 0 ? C2 : 1.0f);
#pragma unroll
                    for (int bj = 0; bj < 2; ++bj)
#pragma unroll
                        for (int k = 0; k < 4; ++k) v2[bj][k] *= (f32x2){gv[bj][2 * k], gv[bj][2 * k + 1]} * hs;
                }
                if (rope_on) {
                    const float posf = (float)(region == 0 ? (row & 4095) : 1024 + (row & 63));
#pragma unroll
                    for (int k = 0; k < 4; ++k) {
                        const f32x2 ir2 = (f32x2){__builtin_amdgcn_exp2f(-(float)(8 * fq + 2 * k) * 0.41524101186f), __builtin_amdgcn_exp2f(-(float)(8 * fq + 2 * k + 1) * 0.41524101186f)} * 0.15915494309f;
                        const f32x2 rv = ir2 * posf;
                        const float r0 = __builtin_amdgcn_fractf(rv.x), r1 = __builtin_amdgcn_fractf(rv.y);
                        const f32x2 c2 = (f32x2){__builtin_amdgcn_cosf(r0), __builtin_amdgcn_cosf(r1)}, s2 = (f32x2){__builtin_amdgcn_sinf(r0), __builtin_amdgcn_sinf(r1)};
                        const f32x2 lo2 = v2[0][k], hi2 = v2[1][k]; v2[0][k] = lo2 * c2 - hi2 * s2; v2[1][k] = lo2 * s2 + hi2 * c2; }
                }
                float v[2][8];
#pragma unroll
                for (int bj = 0; bj < 2; ++bj)
#pragma unroll
                    for (int k = 0; k < 4; ++k) { v[bj][2 * k] = v2[bj][k].x; v[bj][2 * k + 1] = v2[bj][k].y; }
                if (mode == 0) {
#pragma unroll
                    for (int bj = 0; bj < 2; ++bj) { u32x4 w; w.x = cvt_pk_bf16(v[bj][0], v[bj][1]); w.y = cvt_pk_bf16(v[bj][2], v[bj][3]);
                        w.z = cvt_pk_bf16(v[bj][4], v[bj][5]); w.w = cvt_pk_bf16(v[bj][6], v[bj][7]);
                        *(u32x4*)(Q + (size_t)row * D + qcol + 32 * bj + 8 * fq) = w; }
                } else {
                    int vb, tpos, orow;
                    if (region == 0) { const int pos = row & 4095, b = row >> 12; vb = b; tpos = pos; orow = pos >= 4096 - keep ? b * keep + pos - (4096 - keep) : -1; }
                    else if (region == 1) { const int sb = (row - MP) >> 6, t = row & 63; vb = sb; tpos = soff + t; orow = row - MP; }
                    else { vb = (row - M) >> 8; tpos = row & 255; orow = row - M; }
                    bf16* strm = kbase + (size_t)(vb * nh + hh) * vp * 64;
                    if (mode == 1) {
#pragma unroll
                        for (int bj = 0; bj < 2; ++bj) { u32x4 w; w.x = cvt_pk_bf16(v[bj][0], v[bj][1]); w.y = cvt_pk_bf16(v[bj][2], v[bj][3]);
                            w.z = cvt_pk_bf16(v[bj][4], v[bj][5]); w.w = cvt_pk_bf16(v[bj][6], v[bj][7]);
                            *(u32x4*)(strm + kf_off(tpos, 32 * bj + 8 * fq)) = w; }
                    } else {
#pragma unroll
                        for (int bj = 0; bj < 2; ++bj) { bf16* vt = strm + vf_off(tpos, 32 * bj + 8 * fq);
#pragma unroll
                            for (int i = 0; i < 8; i += 2) { const unsigned w = cvt_pk_bf16(v[bj][i], v[bj][i + 1]);
                                vt[i * 8] = (bf16)(w & 0xffffu); vt[(i + 1) * 8] = (bf16)(w >> 16); } }
                    }
                    if (orow >= 0) { float* op = out + obase + (size_t)orow * opitch + hh * 64 + 8 * fq;
#pragma unroll
                        for (int bj = 0; bj < 2; ++bj) { *(f32x4*)(op + 32 * bj) = (f32x4){v[bj][0], v[bj][1], v[bj][2], v[bj][3]}; *(f32x4*)(op + 32 * bj + 4) = (f32x4){v[bj][4], v[bj][5], v[bj][6], v[bj][7]}; }
                    }
                }
            }
    }
};
struct EpiBr {
    static constexpr bool PERM = true, AFTER_DRAIN = false, HOOK = true, RSLDS = false;
    typedef NoRs RsT;
    unsigned char* ws;
    __device__ __forceinline__ void hook(f32x4 (&acc)[2][2][4][2], const Unit& u, int t, int wr, int wc, int fr, int fq) const {
        const int num = (t == 8) ? 0 : 1;
        int tidg = (wr * 4 + wc) * 64 + fq * 16 + fr;
        asm volatile("" : "+v"(tidg));
        const unsigned char* G = ws + WS_H;
        u32x2 a[2][4][2], b[2][4][2];
#pragma unroll
        for (int ai = 0; ai < 2; ++ai)
#pragma unroll
            for (int m = 0; m < 4; ++m)
#pragma unroll
                for (int bj = 0; bj < 2; ++bj) { a[ai][m][bj] = *(const u32x2*)(G + gate_off8(u.pm, num * 4 + u.pn, ai, m, bj, tidg)); b[ai][m][bj] = *(const u32x2*)(G + gate_off8(u.pm, num * 4 + 4 + u.pn, ai, m, bj, tidg)); }
#pragma unroll
        for (int ai = 0; ai < 2; ++ai)
#pragma unroll
            for (int m = 0; m < 4; ++m)
#pragma unroll
                for (int bj = 0; bj < 2; ++bj)
#pragma unroll
                    for (int i = 0; i < 8; i += 2) { const unsigned wa = i < 4 ? a[ai][m][bj].x : a[ai][m][bj].y, wb = i < 4 ? b[ai][m][bj].x : b[ai][m][bj].y;
                        const f32x2 rb = (f32x2){__builtin_amdgcn_rcpf(ub(wb, i & 3)), __builtin_amdgcn_rcpf(ub(wb, (i + 1) & 3))};
                        const f32x2 r2 = (f32x2){ub(wa, i & 3), ub(wa, (i + 1) & 3)} * rb;
                        const f32x2 v2 = (f32x2){acc[ai][bj][m][i >> 2][i & 3], acc[ai][bj][m][i >> 2][(i & 3) + 1]} * r2;
                        acc[ai][bj][m][i >> 2][i & 3] = v2.x; acc[ai][bj][m][i >> 2][(i & 3) + 1] = v2.y; }
    }
    __device__ __forceinline__ void operator()(const f32x4 (&acc)[2][2][4][2], const Unit& u, int wr, int wc, int fr, int fq) const {
        const unsigned char* G = ws + WS_H; bf16* outp = (bf16*)(ws + WS_Q);
        const int row0 = u.pm * 256 + wr * 64 + fr, col0 = u.pn * 256 + wc * 32 + 8 * fq, tidg = (wr * 4 + wc) * 64 + fq * 16 + fr;
        u32x2 a[2][4][2];
#pragma unroll
        for (int ai = 0; ai < 2; ++ai)
#pragma unroll
            for (int m = 0; m < 4; ++m)
#pragma unroll
                for (int bj = 0; bj < 2; ++bj) a[ai][m][bj] = *(const u32x2*)(G + gate_off8(u.pm, 8 + u.pn, ai, m, bj, tidg));
#pragma unroll
        for (int ai = 0; ai < 2; ++ai)
#pragma unroll
            for (int m = 0; m < 4; ++m) {
                const int row = row0 + ai * 128 + m * 16;
#pragma unroll
                for (int bj = 0; bj < 2; ++bj) { u32x4 w;
#pragma unroll
                    for (int j = 0; j < 4; ++j) { const unsigned wa = j < 2 ? a[ai][m][bj].x : a[ai][m][bj].y;
                        const f32x2 g2 = (f32x2){ub(wa, (2 * j) & 3), ub(wa, (2 * j + 1) & 3)} * (1.0f / 255.0f);
                        const f32x2 v2 = (f32x2){acc[ai][bj][m][j >> 1][(j & 1) * 2], acc[ai][bj][m][j >> 1][(j & 1) * 2 + 1]} * g2;
                        w[j] = cvt_pk_bf16(v2.x, v2.y); }
                    *(u32x4*)(outp + (size_t)row * D + col0 + bj * 128) = w; }
            }
    }
};
constexpr int NSLICE = 11, SLICE_NT = 4;
struct OrderSlice {
    int G, c;
    __device__ bool next(int i, Unit& u) const { const int L = i * G + c; if (L >= 16 * NSLICE) return false; const int tile = L & 15; u.ks = L >> 4; u.pm = 256 + (tile >> 2); u.pn = tile & 3; return true; }
    __device__ __forceinline__ void a_ready(const Unit&) const {}
    __device__ __forceinline__ void done(const Unit&) const {}
};
struct EpiPart {
    static constexpr bool PERM = true, AFTER_DRAIN = false, HOOK = false, RSLDS = false;
    typedef NoRs RsT;
    unsigned char* ws;
    __device__ __forceinline__ void operator()(const f32x4 (&acc)[2][2][4][2], const Unit& u, int wr, int wc, int fr, int fq) const {
        float* P = (float*)(ws + WS_PART) + (size_t)u.ks * (1024 * 1024);
        const int row0 = (u.pm - 256) * 256 + wr * 64 + fr, col0 = u.pn * 256 + wc * 32 + 8 * fq;
#pragma unroll
        for (int ai = 0; ai < 2; ++ai)
#pragma unroll
            for (int m = 0; m < 4; ++m)
#pragma unroll
                for (int bj = 0; bj < 2; ++bj) { float* p = P + (size_t)(row0 + ai * 128 + m * 16) * 1024 + col0 + bj * 128; *(f32x4*)p = acc[ai][bj][m][0]; *(f32x4*)(p + 4) = acc[ai][bj][m][1]; }
    }
};
__device__ __forceinline__ float sample_row_sum(const unsigned char* ws, int r, int lane, f32x4 (&xn)[4]) {
    const u32x2* xb = (const u32x2*)((const bf16*)(ws + WS_XB) + (size_t)(MP + r) * D); const float* P = (const float*)(ws + WS_PART) + (size_t)r * 1024;
    float ss = 0.f;
#pragma unroll
    for (int j = 0; j < 4; ++j) {
        const u32x2 o = xb[lane + 64 * j]; f32x4 p[NSLICE];
#pragma unroll
        for (int s_ = 0; s_ < NSLICE; ++s_) p[s_] = ((const f32x4*)(P + (size_t)s_ * (1024 * 1024)))[lane + 64 * j];
        f32x4 a = p[0];
#pragma unroll
        for (int s_ = 1; s_ < NSLICE; ++s_) a += p[s_];
        xn[j] = (f32x4){bf_lo(o.x), bf_hi(o.x), bf_lo(o.y), bf_hi(o.y)} + a * 0.5f;
        ss += (xn[j][0] * xn[j][0] + xn[j][1] * xn[j][1]) + (xn[j][2] * xn[j][2] + xn[j][3] * xn[j][3]);
    }
#pragma unroll
    for (int o_ = 1; o_ < 64; o_ <<= 1) ss += __shfl_xor(ss, o_);
    return ss;
}
struct OrderIn {
    pg8::StaticOrder base; int G, c;
    __device__ void init(int G_, int c_) { base.init(M, N_IN, G_, c_); G = G_; c = c_; }
    __device__ bool next(int i, Unit& u) const {
        const long L = (long)i * G + c; if (L < base.nwg) return base.next(i, u);
        const int r = (int)(L - base.nwg); if (r >= 32) return false;
        u.pm = 260 + (r >> 1); u.pn = 19 + (r & 1); u.ks = 0; return true;
    }
    __device__ __forceinline__ void a_ready(const Unit&) const {}
    __device__ __forceinline__ void done(const Unit&) const {}
};

__device__ __forceinline__ float max3f(float a, float b, float c) { float r; asm("v_max3_f32 %0, %1, %2, %3" : "=v"(r) : "v"(a), "v"(b), "v"(c)); return r; }
__device__ __forceinline__ int crow(int r, int hi) { return (r & 3) + 8 * (r >> 2) + 4 * hi; }
__device__ __forceinline__ void attn_task(const bf16* Qp, const bf16* Kp, const bf16* Vtp, int ntiles, bool has_sink, float sink2,
                                          bool has_bias, const LAS float* biasl, int j0, int qin, bf16* Yp, int lane) {
    const int r32 = lane & 31, hi = lane >> 5;
    bf16x8 qr[4];
#pragma unroll
    for (int d0 = 0; d0 < 4; ++d0) qr[d0] = *(const bf16x8*)(Qp + (size_t)r32 * D + d0 * 16 + hi * 8);
    f32x16 o0 = {}, o1 = {};
    float mrun = 0.f, lsum = 0.f;
    const bf16* kp = Kp + lane * 8;
    const bf16* vp = Vtp + lane * 8;
    bf16x8 kf[2][4], vf[2][4], kn[2][4], vn[2][4];
#define ATT_LOAD(KF, VF, IT) do { \
    _Pragma("unroll") for (int blk = 0; blk < 2; ++blk) _Pragma("unroll") for (int d0 = 0; d0 < 4; ++d0) KF[blk][d0] = *(const bf16x8*)(kp + ((2 * (IT) + blk) * 4 + d0) * 512); \
    _Pragma("unroll") for (int d0 = 0; d0 < 2; ++d0) _Pragma("unroll") for (int ks = 0; ks < 4; ++ks) VF[d0][ks] = *(const bf16x8*)(vp + ((2 * (IT) + d0) * 4 + ks) * 512); } while (0)
    ATT_LOAD(kf, vf, 0);
    for (int it = 0; it < ntiles; ++it) {
        if (it + 1 < ntiles) ATT_LOAD(kn, vn, it + 1);
        f32x16 p0 = {}, p1 = {};
#pragma unroll
        for (int d0 = 0; d0 < 4; ++d0) { p0 = __builtin_amdgcn_mfma_f32_32x32x16_bf16(kf[0][d0], qr[d0], p0, 0, 0, 0); p1 = __builtin_amdgcn_mfma_f32_32x32x16_bf16(kf[1][d0], qr[d0], p1, 0, 0, 0); }
        if (has_bias) {
            const int j = j0 - it;
            if (j >= 3) { const float bc = biasl[256];
#pragma unroll
                for (int r = 0; r < 16; ++r) { p0[r] += bc; p1[r] += bc; } }
            else { const int base = 64 * j + qin + r32 + 128 - 4 * hi;
#pragma unroll
                for (int r = 0; r < 16; ++r) { const int kvl = (r & 3) + 8 * (r >> 2); int i0 = base - kvl, i1 = base - kvl - 32; i0 = i0 > 256 ? 256 : i0; i1 = i1 > 256 ? 256 : i1;
                    p0[r] += biasl[i0]; p1[r] += biasl[i1]; } }
        }
        float mx;
        { float ma = max3f(p0[0], p0[1], p1[0]), mb = max3f(p0[2], p0[3], p1[1]); ma = max3f(ma, p1[2], p1[3]);
#pragma unroll
          for (int r = 4; r < 16; r += 4) { ma = max3f(ma, p0[r], p0[r + 1]); mb = max3f(mb, p0[r + 2], p0[r + 3]); ma = max3f(ma, p1[r], p1[r + 1]); mb = max3f(mb, p1[r + 2], p1[r + 3]); }
          mx = fmaxf(ma, mb); }
        { const auto rr = __builtin_amdgcn_permlane32_swap(__float_as_uint(mx), __float_as_uint(mx), false, false);
          mx = fmaxf(__uint_as_float(rr[0]), __uint_as_float(rr[1])) - mrun; }
        if (it == 0 || __any(mx > 8.0f)) {
            const float delta = it == 0 ? mx : fmaxf(mx, 0.f), alpha = __builtin_amdgcn_exp2f(-delta);
            mrun += delta; lsum *= alpha;
#pragma unroll
            for (int r = 0; r < 16; ++r) { o0[r] *= alpha; o1[r] *= alpha; }
        }
        f32x2 ps2 = (f32x2){0.f, 0.f};
#pragma unroll
        for (int r = 0; r < 16; r += 2) {
            const f32x2 a0 = (f32x2){p0[r], p0[r + 1]} - mrun, a1 = (f32x2){p1[r], p1[r + 1]} - mrun;
            p0[r] = __builtin_amdgcn_exp2f(a0.x); p0[r + 1] = __builtin_amdgcn_exp2f(a0.y); p1[r] = __builtin_amdgcn_exp2f(a1.x); p1[r + 1] = __builtin_amdgcn_exp2f(a1.y);
            ps2 += (f32x2){p0[r], p0[r + 1]} + (f32x2){p1[r], p1[r + 1]};
        }
        lsum += ps2.x + ps2.y;
        bf16x8 pk[4];
#pragma unroll
        for (int ks = 0; ks < 4; ++ks) { u32x4 w;
#pragma unroll
            for (int j = 0; j < 4; ++j) { const int r = 8 * (ks & 1) + 2 * j; w[j] = (ks < 2) ? cvt_pk_bf16(p0[r], p0[r + 1]) : cvt_pk_bf16(p1[r], p1[r + 1]); }
            pk[ks] = __builtin_bit_cast(bf16x8, w); }
#pragma unroll
        for (int ks = 0; ks < 4; ++ks) { o0 = __builtin_amdgcn_mfma_f32_32x32x16_bf16(vf[0][ks], pk[ks], o0, 0, 0, 0); o1 = __builtin_amdgcn_mfma_f32_32x32x16_bf16(vf[1][ks], pk[ks], o1, 0, 0, 0); }
#pragma unroll
        for (int a = 0; a < 2; ++a)
#pragma unroll
            for (int b = 0; b < 4; ++b) { kf[a][b] = kn[a][b]; vf[a][b] = vn[a][b]; }
    }
#undef ATT_LOAD
    float l; { const auto rr = __builtin_amdgcn_permlane32_swap(__float_as_uint(lsum), __float_as_uint(lsum), false, false); l = __uint_as_float(rr[0]) + __uint_as_float(rr[1]); }
    if (has_sink) l += __builtin_amdgcn_exp2f(sink2 - mrun);
    const float inv = 1.0f / l;
    bf16* yp = Yp + (size_t)r32 * D + 8 * hi;
#pragma unroll
    for (int rg = 0; rg < 4; rg += 2) {
#pragma unroll
        for (int d0 = 0; d0 < 2; ++d0) {
            u32x2 a_, b_;
            if (d0 == 0) { a_.x = cvt_pk_bf16(o0[4 * rg] * inv, o0[4 * rg + 1] * inv); a_.y = cvt_pk_bf16(o0[4 * rg + 2] * inv, o0[4 * rg + 3] * inv);
                           b_.x = cvt_pk_bf16(o0[4 * rg + 4] * inv, o0[4 * rg + 5] * inv); b_.y = cvt_pk_bf16(o0[4 * rg + 6] * inv, o0[4 * rg + 7] * inv); }
            else         { a_.x = cvt_pk_bf16(o1[4 * rg] * inv, o1[4 * rg + 1] * inv); a_.y = cvt_pk_bf16(o1[4 * rg + 2] * inv, o1[4 * rg + 3] * inv);
                           b_.x = cvt_pk_bf16(o1[4 * rg + 4] * inv, o1[4 * rg + 5] * inv); b_.y = cvt_pk_bf16(o1[4 * rg + 6] * inv, o1[4 * rg + 7] * inv); }
            { const auto r_ = __builtin_amdgcn_permlane32_swap(a_.x, b_.x, false, false); a_.x = r_[0]; b_.x = r_[1]; }
            { const auto r_ = __builtin_amdgcn_permlane32_swap(a_.y, b_.y, false, false); a_.y = r_[0]; b_.y = r_[1]; }
            *(u32x4*)(yp + 32 * d0 + 8 * rg) = (u32x4){a_.x, a_.y, b_.x, b_.y};
        }
    }
}

#define XB_TMO      128
#define XB_XCNT(j)  (256  + 64 * (j))
#define XB_XSUB(j)  (1280 + 64 * (j))
#define XB_XGEN(j)  (2304 + 64 * (j))
#define XB_TOP      3328
#define XB_TOPGEN   3392
#define XCD_BAR_WORDS 3456
#define XB_SPIN_CAP (1u << 18)

__device__ __forceinline__ unsigned xb_ld(unsigned* p)              { return __hip_atomic_load(p, __ATOMIC_RELAXED, __HIP_MEMORY_SCOPE_AGENT); }
__device__ __forceinline__ unsigned xb_add(unsigned* p, unsigned v) { return __hip_atomic_fetch_add(p, v, __ATOMIC_RELAXED, __HIP_MEMORY_SCOPE_AGENT); }
__device__ __forceinline__ unsigned xb_xcc_id() { return (unsigned)__builtin_amdgcn_s_getreg((3 << 11) | 20) & 0xFu; }
#define XB_SPIN(cond, bar) do { unsigned _sp = 0; while (cond) { __builtin_amdgcn_s_sleep(1); \
    if ((++_sp & 255u) == 0u) { if (xb_ld(&(bar)[XB_TMO])) break; if (_sp > XB_SPIN_CAP) { atomicAdd(&(bar)[XB_TMO], 1u); break; } } } } while (0)

struct XcdBarrier {
    unsigned* bar; unsigned x; int w0;
    volatile LAS unsigned* st;
};

__device__ __forceinline__ XcdBarrier xcd_barrier_post(unsigned* bar, volatile LAS unsigned* st) {
    XcdBarrier b; b.bar = bar; b.x = xb_xcc_id(); b.st = st;
    if (threadIdx.x == 0) (void)xb_add(&bar[XB_XCNT(b.x)], 1u);
    return b;
}
__device__ __forceinline__ void xcd_barrier_complete(unsigned* bar, unsigned x, unsigned& nloc, unsigned& nx) {
    const unsigned G = gridDim.x * gridDim.y * gridDim.z;
    unsigned sum, cnt, mine, sp = 0u;
    for (;;) {
        sum = 0u; cnt = 0u; mine = 0u;
#pragma unroll
        for (unsigned j = 0; j < 16; ++j) { const unsigned c = xb_ld(&bar[XB_XCNT(j)]); sum += c; cnt += (c > 0u) ? 1u : 0u; mine = (j == x) ? c : mine; }
        if (sum == G) break;
        __builtin_amdgcn_s_sleep(1);
        if ((++sp & 255u) == 0u) { if (xb_ld(&bar[XB_TMO])) break; if (sp > XB_SPIN_CAP) { atomicAdd(&bar[XB_TMO], 1u); break; } }
    }
    nloc = mine > 0u ? mine : 1u; nx = cnt > 0u ? cnt : 1u;
}

__device__ __forceinline__ void xcd_barrier(const XcdBarrier& b) {
    asm volatile("s_waitcnt vmcnt(0)" ::: "memory");
    __syncthreads();
    if (b.w0 && lane_id() == 0) {
        unsigned* bar = b.bar;
        __builtin_amdgcn_s_waitcnt(0);
        unsigned nloc = b.st[0], nx = b.st[1];
        if (nloc == 0u) { xcd_barrier_complete(bar, b.x, nloc, nx); b.st[0] = nloc; b.st[1] = nx; }
        const unsigned old = xb_add(&bar[XB_XSUB(b.x)], 1u);
        const unsigned gen = old / nloc;
        if (old + 1u == (gen + 1u) * nloc) {
            __builtin_amdgcn_fence(__ATOMIC_RELEASE, "agent");
            asm volatile("s_waitcnt vmcnt(0)" ::: "memory");
            const unsigned og = xb_add(&bar[XB_TOP], 1u);
            const unsigned tg = og / nx;
            if (og + 1u == (tg + 1u) * nx) xb_add(&bar[XB_TOPGEN], 1u);
            else XB_SPIN(xb_ld(&bar[XB_TOPGEN]) == tg, bar);
            __builtin_amdgcn_fence(__ATOMIC_ACQUIRE, "agent");
            xb_add(&bar[XB_XGEN(b.x)], 1u);
            asm volatile("s_waitcnt vmcnt(0)" ::: "memory");
        } else {
            XB_SPIN(xb_ld(&bar[XB_XGEN(b.x)]) == gen, bar);
            __builtin_amdgcn_fence(__ATOMIC_ACQUIRE, "agent");
            asm volatile("s_waitcnt vmcnt(0)" ::: "memory");
        }
    }
    __syncthreads();
}

struct Args { const float* in[36]; float* out; unsigned char* ws; int ph_lo, ph_hi; };

__device__ __forceinline__ float wave_sum(float v) {
#pragma unroll
    for (int o = 1; o < 64; o <<= 1) v += __shfl_xor(v, o);
    return v;
}
__device__ __forceinline__ void tr_item(const float* W, int K, int N, const float* gain, bf16* WT, int pitch, int koff, int mapkind, int rowoff, LAS float* scr, int item, int lane) {
    const int nblk = N / 32, kb = item / nblk, nb = item % nblk, k0 = 64 * kb, n0 = 32 * nb;
#pragma unroll 8
    for (int i = 0; i < 32; ++i) { const int kk = 2 * i + (lane >> 5); float w = W[(size_t)(k0 + kk) * N + n0 + (lane & 31)]; if (gain) w *= gain[k0 + kk]; scr[kk * 33 + (lane & 31)] = w; }
    asm volatile("s_waitcnt lgkmcnt(0)" ::: "memory");
    int drow0;
    if (mapkind == 0) drow0 = n0;
    else if (mapkind == 1) drow0 = 256 * (n0 / 128) + (n0 % 128);
    else if (mapkind == 2) drow0 = 256 * (n0 / 128) + 128 + (n0 % 128);
    else { const int tile = n0 / 256, hh = (n0 % 256) / 64, dd = n0 % 64; drow0 = 256 * tile + 128 * (dd / 32) + 32 * hh; }
    drow0 += rowoff;
    const int c = lane & 7;
#pragma unroll
    for (int j = 0; j < 4; ++j) { const int n = (lane >> 3) + 8 * j; const LAS float* s = scr + (8 * c) * 33 + n;
        u32x4 o; o.x = cvt_pk_bf16(s[0 * 33], s[1 * 33]); o.y = cvt_pk_bf16(s[2 * 33], s[3 * 33]); o.z = cvt_pk_bf16(s[4 * 33], s[5 * 33]); o.w = cvt_pk_bf16(s[6 * 33], s[7 * 33]);
        *(u32x4*)(WT + (size_t)(drow0 + n) * pitch + koff + k0 + 8 * c) = o; }
    asm volatile("s_waitcnt lgkmcnt(0)" ::: "memory");
}
__device__ const double INVF[32] = {1.0, 0.7498942093324559, 0.5623413251903491, 0.4216965034285822, 0.31622776601683794, 0.23713737056616552, 0.1778279410038923, 0.1333521432163324,
    0.1, 0.07498942093324558, 0.05623413251903491, 0.042169650342858224, 0.03162277660168379, 0.023713737056616554, 0.01778279410038923, 0.01333521432163324,
    0.01, 0.007498942093324558, 0.005623413251903491, 0.004216965034285823, 0.0031622776601683794, 0.0023713737056616554, 0.0017782794100389228, 0.001333521432163324,
    0.001, 0.0007498942093324559, 0.0005623413251903491, 0.00042169650342858224, 0.00031622776601683794, 0.00023713737056616554, 0.00017782794100389227, 0.0001333521432163324};

__global__ void __launch_bounds__(NTHREADS, 2) mega(Args args) {
    extern __shared__ __attribute__((aligned(16))) unsigned char lds_raw[];
    LAS unsigned char* lds = (LAS unsigned char*)lds_raw;
    const int wave_s = __builtin_amdgcn_readfirstlane((int)threadIdx.x >> 6);
#define TIDS() int tid = wave_s * 64 + lane_id(); const int lane = tid & 63, wave = wave_s; (void)lane; (void)wave
    const int G = gridDim.x;
    int bx = blockIdx.x;
    int vcu = (G % 8 == 0) ? (bx % 8) * (G / 8) + bx / 8 : bx;
    float* out = args.out;
#define WSP(name) unsigned char* name = args.ws; asm volatile("" : "+s"(name))
#define PTR(T, base, off) ((T*)((base) + (off)))
    const float* const* in = args.in;
    const int lo = args.ph_lo, hi = args.ph_hi;
#define IN(k) (lo <= (k) && (k) < hi)
#if MK_MULTI
#define GRID_SYNC() do { } while (0)
#else
    cg::grid_group grid = cg::this_grid();
    volatile LAS unsigned* MISC = (volatile LAS unsigned*)(lds + RING_BYTES + 512);
    if (threadIdx.x == 0) { MISC[0] = 0u; MISC[1] = 0u; }
    __syncthreads();
    XcdBarrier xbar; xbar.bar = (unsigned*)args.ws; xbar.x = xb_xcc_id(); xbar.st = MISC; xbar.w0 = (wave_s == 0);
    if (threadIdx.x == 0) MISC[2] = xb_add(&xbar.bar[XB_XCNT(xbar.x)], 1u);
    __syncthreads();
#define GRID_SYNC() xcd_barrier(xbar)
#endif

#if PROBE_DUP == 10
    for (int rep0_ = 0; rep0_ < 2; ++rep0_)
#endif
    if (IN(0) && !SKIP_P0) {
        TIDS();
        WSP(w0);
        bf16 *WUP1 = PTR(bf16, w0, WS_WUP1), *WDN1 = PTR(bf16, w0, WS_WDN1), *WUP2 = PTR(bf16, w0, WS_WUP2), *WDN2 = PTR(bf16, w0, WS_WDN2), *WIN = PTR(bf16, w0, WS_WIN),
             *WBR = PTR(bf16, w0, WS_WBR), *WOUT = PTR(bf16, w0, WS_WOUT), *KAS = PTR(bf16, w0, WS_KAS), *VTAS = PTR(bf16, w0, WS_VTAS), *KBS = PTR(bf16, w0, WS_KBS),
             *VTBS = PTR(bf16, w0, WS_VTBS), *MKS = PTR(bf16, w0, WS_MKS), *MVTS = PTR(bf16, w0, WS_MVTS), *XB = PTR(bf16, w0, WS_XB);
        float* SSQ = PTR(float, w0, WS_SSQ); f32x2* ROPE = PTR(f32x2, w0, WS_ROPE);
        LAS float* scr = (LAS float*)(lds + wave * 16384);
        const int gw = vcu * NWAVES + wave, NGW = G * NWAVES;
        constexpr int I_UPH = 16 * 88, I_DN = 44 * 32, I_IN = 16 * 56, I_GT = 16 * 96, I_MEM = 16 * 16, I_BRA = 8 * 32, I_BRB = 4 * 32, I_OUT = 16 * 32;
        constexpr int NITEMS = 4 * I_UPH + 2 * I_DN + I_IN + I_GT + I_MEM + I_BRA + 2 * I_BRB + I_OUT;
        for (int it = gw; it < NITEMS; it += NGW) {
            int r = it;
            if (r < I_UPH) { tr_item(in[10], D, FF, in[9], WUP1, D, 0, 1, 0, scr, r, lane); continue; } r -= I_UPH;
            if (r < I_UPH) { tr_item(in[11], D, FF, in[9], WUP1, D, 0, 2, 0, scr, r, lane); continue; } r -= I_UPH;
            if (r < I_DN)  { tr_item(in[12], FF, D, nullptr, WDN1, FF, 0, 0, 0, scr, r, lane); continue; } r -= I_DN;
            if (r < I_UPH) { tr_item(in[32], D, FF, in[31], WUP2, D, 0, 1, 0, scr, r, lane); continue; } r -= I_UPH;
            if (r < I_UPH) { tr_item(in[33], D, FF, in[31], WUP2, D, 0, 2, 0, scr, r, lane); continue; } r -= I_UPH;
            if (r < I_DN)  { tr_item(in[34], FF, D, nullptr, WDN2, FF, 0, 0, 0, scr, r, lane); continue; } r -= I_DN;
            if (r < I_IN)  { tr_item(in[14], D, 1792, in[13], WIN, D, 0, 3, 0, scr, r, lane); continue; } r -= I_IN;
            if (r < I_GT)  { tr_item(in[25], D, 3072, in[13], WIN, D, 0, 0, 1792, scr, r, lane); continue; } r -= I_GT;
            if (r < I_MEM) { tr_item(in[23], D, 512, in[22], WIN, D, 0, 3, N_IN, scr, r, lane); continue; } r -= I_MEM;
            if (r < I_BRA) { tr_item(in[27], 512, D, nullptr, WBR, D, 0, 0, 0, scr, r, lane); continue; } r -= I_BRA;
            if (r < I_BRB) { tr_item(in[28], 256, D, nullptr, WBR, D, 512, 0, 0, scr, r, lane); continue; } r -= I_BRB;
            if (r < I_BRB) { tr_item(in[29], 256, D, nullptr, WBR, D, 768, 0, 0, scr, r, lane); continue; } r -= I_BRB;
            tr_item(in[30], D, D, nullptr, WOUT, D, 0, 0, 0, scr, r, lane);
        }
        for (int r = gw; r < MA; r += NGW) {
            const float* src = r < MP ? in[0] + (size_t)r * D : (r < M ? in[1] + (size_t)(r - MP) * D : in[8] + (size_t)(r - M) * D);
            f32x4 v[4]; float ss = 0.f;
#pragma unroll
            for (int j = 0; j < 4; ++j) { v[j] = ((const f32x4*)src)[lane + 64 * j]; ss += (v[j][0] * v[j][0] + v[j][1] * v[j][1]) + (v[j][2] * v[j][2] + v[j][3] * v[j][3]); }
            ss = wave_sum(ss);
            u32x2* o8 = (u32x2*)(XB + (size_t)r * D);
#pragma unroll
            for (int j = 0; j < 4; ++j) { u32x2 w; w.x = cvt_pk_bf16(v[j][0], v[j][1]); w.y = cvt_pk_bf16(v[j][2], v[j][3]); o8[lane + 64 * j] = w; }
            if (lane < 16) SSQ[(size_t)r * 16 + lane] = lane == 0 ? ss : 0.f;
        }
        const int gt = vcu * NTHREADS + tid, NTH = G * NTHREADS;
        for (int i = gt; i < 16 * 128 * 128; i += NTH) { const int sb = i >> 14, t = (i >> 7) & 127, c = i & 127;
            const size_t so = (size_t)(sb * 2 + (c >> 6)) * 192 * 64;
            KAS[so + kf_off(t, c & 63)] = (bf16)(cvt_pk_bf16(in[2][i], 0.f) & 0xffffu);
            VTAS[so + vf_off(t, c & 63)] = (bf16)(cvt_pk_bf16(in[3][i], 0.f) & 0xffffu); }
        for (int i = gt; i < 16 * 512 * 256; i += NTH) { const int sb = i >> 17, t = (i >> 8) & 511, c = i & 255;
            const size_t so = (size_t)(sb * 4 + (c >> 6)) * 576 * 64;
            KBS[so + kf_off(t, c & 63)] = (bf16)(cvt_pk_bf16(in[4][i], 0.f) & 0xffffu);
            VTBS[so + vf_off(t, c & 63)] = (bf16)(cvt_pk_bf16(in[5][i], 0.f) & 0xffffu); }
        for (int i = gt; i < 16 * 256 * 256; i += NTH) { const int sb = i >> 16, t = (i >> 8) & 255, c = i & 255;
            const size_t so = (size_t)(sb * 4 + (c >> 6)) * 256 * 64;
            MKS[so + kf_off(t, c & 63)] = (bf16)(cvt_pk_bf16(in[6][i], 0.f) & 0xffffu);
            MVTS[so + vf_off(t, c & 63)] = (bf16)(cvt_pk_bf16(in[7][i], 0.f) & 0xffffu); }
    }
#if MK_MULTI
    if (IN(0) && IN(1)) GRID_SYNC();
#else
    if (IN(0) && IN(1)) grid.sync();
    {
        unsigned* ctl = (unsigned*)args.ws; bool even = (G % 8 == 0);
        for (int j = 0; j < 8; ++j) even = even && (xb_ld(&ctl[XB_XCNT(j)]) == (unsigned)(G / 8));
        const int rk = (int)MISC[2], xc = (int)xbar.x;
        if (even && xc < 8 && rk < G / 8) { bx = rk * 8 + xc; vcu = xc * (G / 8) + rk; }
    }
#endif

#pragma unroll 1
    for (int pass = 0; pass < 2; ++pass) {
        const int ph = pass == 0 ? 1 : 7;
        if (IN(ph) && !SKIP_UP) {
            WSP(w1);
            pg8::Gemm g{PTR(bf16, w1, WS_XB), pass == 0 ? PTR(bf16, w1, WS_WUP1) : PTR(bf16, w1, WS_WUP2), M, N_UP, D, D / 64}; pg8::StaticOrder S; S.init(M, N_UP, G, bx);
            EpiUp E{w1};
            __syncthreads();
            pg8::gemm_phase<EpiUp, pg8::StaticOrder, PG8_ALIGN, PG8_SP2>(lds, g, S, E, wave_s);
#if PROBE_DUP == 1
            if (pass == 0) { __syncthreads(); pg8::gemm_phase<EpiUp, pg8::StaticOrder, PG8_ALIGN, PG8_SP2>(lds, g, S, E, wave_s); }
#endif
        }
        if (IN(ph) && IN(ph + 1)) GRID_SYNC();
        if (IN(ph + 1) && !SKIP_DN) {
            WSP(w2);
            pg8::Gemm g{PTR(bf16, w2, WS_H), pass == 0 ? PTR(bf16, w2, WS_WDN1) : PTR(bf16, w2, WS_WDN2), MP, D, FF, FF / 64}; pg8::StaticOrder S; S.init(MP, D, G, bx);
            EpiRes E{w2, 0.5f};
            __syncthreads();
            pg8::gemm_phase<EpiRes, pg8::StaticOrder, PG8_ALIGN, PG8_SP2>(lds, g, S, E, wave_s);
            pg8::Gemm g2{g.A, g.Bt, M, D, FF, SLICE_NT}; OrderSlice S2{G, bx}; EpiPart E2{w2};
            __syncthreads();
            pg8::gemm_phase<EpiPart, OrderSlice, PG8_ALIGN, PG8_SP2>(lds, g2, S2, E2, wave_s);
        }
        if (IN(ph + 1) && IN(ph + 2)) GRID_SYNC();
        if (pass == 1) break;
        if (IN(2)) {
            TIDS(); WSP(wf);
            const int gw = vcu * NWAVES + wave;
            if (gw < MSAMP) {
                f32x4 xn[4]; const float ss = sample_row_sum(wf, gw, lane, xn);
                u32x2* o8 = (u32x2*)(PTR(bf16, wf, WS_XB) + (size_t)(MP + gw) * D);
#pragma unroll
                for (int j = 0; j < 4; ++j) { u32x2 w; w.x = cvt_pk_bf16(xn[j][0], xn[j][1]); w.y = cvt_pk_bf16(xn[j][2], xn[j][3]); o8[lane + 64 * j] = w; }
                if (lane < 16) PTR(float, wf, WS_SSQ)[(size_t)(MP + gw) * 16 + lane] = lane == 0 ? ss : 0.f;
            }
        }
        if (IN(2) && IN(3)) GRID_SYNC();
        if (IN(3) && !SKIP_IN) {
            WSP(w3);
            pg8::Gemm g{PTR(bf16, w3, WS_XB), PTR(bf16, w3, WS_WIN), MA, N_INALL, D, D / 64}; OrderIn S; S.init(G, bx);
            EpiIn E{in, w3, out};
            __syncthreads();
            pg8::gemm_phase<EpiIn, OrderIn, PG8_ALIGN, PG8_SP2>(lds, g, S, E, wave_s);
#if PROBE_DUP == 3
            __syncthreads(); pg8::gemm_phase<EpiIn, OrderIn, PG8_ALIGN, PG8_SP2>(lds, g, S, E, wave_s);
#endif
        }
        if (IN(3) && IN(4)) GRID_SYNC();
        if (IN(4) && !SKIP_AT) {
            TIDS();
            WSP(w4);
            bf16 *KAS = PTR(bf16, w4, WS_KAS), *VTAS = PTR(bf16, w4, WS_VTAS), *KBS = PTR(bf16, w4, WS_KBS), *VTBS = PTR(bf16, w4, WS_VTBS), *MKS = PTR(bf16, w4, WS_MKS),
                 *MVTS = PTR(bf16, w4, WS_MVTS), *MKP = PTR(bf16, w4, WS_MKP), *MVTP = PTR(bf16, w4, WS_MVTP), *KAP = PTR(bf16, w4, WS_KAP), *VTAP = PTR(bf16, w4, WS_VTAP),
                 *KBP = PTR(bf16, w4, WS_KBP), *VTBP = PTR(bf16, w4, WS_VTBP), *QB = PTR(bf16, w4, WS_Q), *YB = PTR(bf16, w4, WS_Y);
            LAS float* biasl = (LAS float*)(lds + BIAS_OFF);
            for (int i = tid; i < 4 * 257; i += NTHREADS) biasl[i] = in[20][i] * LOG2E;
            __syncthreads();
            const int lane_o = lane;
            const int half = wave & 1, w2 = wave >> 1;
#if PROBE_DUP == 4
            for (int rep_ = 0; rep_ < 2; ++rep_)
#endif
            for (int ui_ = 0; ui_ < (G == 256 ? 19 : 4160); ++ui_) {
                int un;
                if (G == 256) {
                    const int v = vcu;
                    if (ui_ < 4) un = 256 * ui_ + (v & ~63) + ((v + 16 * ui_) & 63);
                    else if (ui_ == 4) un = v < 16 ? 1024 + v : -1;
                    else if (ui_ < 9) un = 1040 + v + 256 * (ui_ - 5);
                    else if (ui_ == 9) un = v >= 240 ? 2064 + (v - 240) : -1;
                    else { const int j = ui_ - 10, w = v - 16, n = v < 16 ? 5 : 8 + (w < 80 ? 1 : 0), st = v < 16 ? 5 * v : 80 + 8 * w + (w < 80 ? w : 80);
                        un = j < n ? 2080 + st + j : -1; }
                    if (un < 0) continue;
                } else { un = vcu + ui_ * G; if (un >= 4160) break; }
                if (un < 1040) {
                    const int bc = un, h = w2; const bf16 *Kp, *Vtp; int nt;
                    if (bc < 1024) { const int b = bc >> 6, c = bc & 63, cs = c > 8 ? c - 8 : 0; nt = c - cs + 1;
                        const size_t so = (size_t)(b * 4 + h) * 4096 * 64 + (size_t)cs * 4096; Kp = KBP + so; Vtp = VTBP + so; }
                    else { const int sb = bc - 1024; nt = 9; const size_t so = (size_t)(sb * 4 + h) * 576 * 64; Kp = KBS + so; Vtp = VTBS + so; }
                    attn_task(QB + (size_t)(bc * 64 + half * 32) * D + 512 + h * 64, Kp, Vtp, nt, false, 0.f, true, biasl + h * 257, nt - 1, half * 32,
                              YB + (size_t)(bc * 64 + half * 32) * D + 512 + h * 64, lane_o);
                } else if (un < 2080) {
                    const int bc = un - 1040, h = w2; const bf16 *Kp, *Vtp;
                    if (bc < 1024) { const int b = bc >> 6; const size_t so = (size_t)(b * 4 + h) * 256 * 64; Kp = MKP + so; Vtp = MVTP + so; }
                    else { const int sb = bc - 1024; const size_t so = (size_t)(sb * 4 + h) * 256 * 64; Kp = MKS + so; Vtp = MVTS + so; }
                    attn_task(QB + (size_t)(bc * 64 + half * 32) * D + 768 + h * 64, Kp, Vtp, 4, false, 0.f, false, biasl, 0, 0,
                              YB + (size_t)(bc * 64 + half * 32) * D + 768 + h * 64, lane_o);
                } else {
                    const int u2 = un - 2080, bc = u2 >> 1, kvh = u2 & 1, hq = 4 * kvh + w2; const bf16 *Kp, *Vtp; int nt;
                    if (bc < 1024) { const int b = bc >> 6, c = bc & 63, cs = c > 2 ? c - 2 : 0; nt = c - cs + 1;
                        const size_t so = (size_t)(b * 2 + kvh) * 4096 * 64 + (size_t)cs * 4096; Kp = KAP + so; Vtp = VTAP + so; }
                    else { const int sb = bc - 1024; nt = 3; const size_t so = (size_t)(sb * 2 + kvh) * 192 * 64; Kp = KAS + so; Vtp = VTAS + so; }
                    attn_task(QB + (size_t)(bc * 64 + half * 32) * D + hq * 64, Kp, Vtp, nt, true, in[17][hq] * LOG2E, false, biasl, 0, 0,
                              YB + (size_t)(bc * 64 + half * 32) * D + hq * 64, lane_o);
                }
            }
        }
        if (IN(4) && IN(5)) GRID_SYNC();
        if (IN(5) && !SKIP_BR) {
            WSP(w5);
            pg8::Gemm g{PTR(bf16, w5, WS_Y), PTR(bf16, w5, WS_WBR), M, D, D, D / 64}; pg8::StaticOrder S; S.init(M, D, G, bx);
            EpiBr E{w5};
            __syncthreads();
            pg8::gemm_phase<EpiBr, pg8::StaticOrder, PG8_ALIGN, PG8_SP2>(lds, g, S, E, wave_s);
#if PROBE_DUP == 5
            __syncthreads(); pg8::gemm_phase<EpiBr, pg8::StaticOrder, PG8_ALIGN, PG8_SP2>(lds, g, S, E, wave_s);
#endif
        }
        if (IN(5) && IN(6)) GRID_SYNC();
        if (IN(6) && !SKIP_OUT) {
            WSP(w6);
            pg8::Gemm g{PTR(bf16, w6, WS_Q), PTR(bf16, w6, WS_WOUT), M, D, D, D / 64}; pg8::StaticOrder S; S.init(M, D, G, bx);
            EpiRes E{w6, 1.0f};
            __syncthreads();
            pg8::gemm_phase<EpiRes, pg8::StaticOrder, PG8_ALIGN, PG8_SP2>(lds, g, S, E, wave_s);
        }
        if (IN(6) && IN(7)) GRID_SYNC();
    }
    if (IN(9)) {
        TIDS();
        const int gw = vcu * NWAVES + wave, NGW = G * NWAVES;
        WSP(w9); const float* SSQ9 = PTR(float, w9, WS_SSQ);
        const f32x4* gf = (const f32x4*)in[35];
        f32x4 gg[4];
#pragma unroll
        for (int j = 0; j < 4; ++j) gg[j] = gf[lane + 64 * j];
        const bf16* XB9 = PTR(bf16, w9, WS_XB);
        for (int r = gw * 4; r < MP; r += NGW * 4) {
            u32x2 v[4][4]; f32x4 pr[4];
#pragma unroll
            for (int k = 0; k < 4; ++k) { pr[k] = *(const f32x4*)(SSQ9 + (size_t)(r + k) * 16 + 4 * (lane & 3));
#pragma unroll
                for (int j = 0; j < 4; ++j) v[k][j] = ((const u32x2*)(XB9 + (size_t)(r + k) * D))[lane + 64 * j]; }
#pragma unroll
            for (int k = 0; k < 4; ++k) {
                float s_ = (pr[k][0] + pr[k][1]) + (pr[k][2] + pr[k][3]); s_ += __shfl_xor(s_, 1); s_ += __shfl_xor(s_, 2);
                const float rs = rsqrtf(s_ * (1.0f / 1024.0f) + EPS);
                f32x4* p = (f32x4*)(out + (size_t)(r + k) * D);
#pragma unroll
                for (int j = 0; j < 4; ++j) { const f32x4 x = (f32x4){bf_lo(v[k][j].x), bf_hi(v[k][j].x), bf_lo(v[k][j].y), bf_hi(v[k][j].y)}; p[lane + 64 * j] = x * rs * gg[j]; }
            }
        }
        if (gw < MSAMP) {
            f32x4 xn[4]; const float ss = sample_row_sum(w9, gw, lane, xn);
            const float rs = rsqrtf(ss * (1.0f / 1024.0f) + EPS);
            f32x4* p = (f32x4*)(out + (size_t)(MP + gw) * D);
#pragma unroll
            for (int j = 0; j < 4; ++j) p[lane + 64 * j] = xn[j] * rs * gg[j];
        }
    }
#undef IN
}

extern "C" void kernel_launch(void* const* d_in, const int* in_sizes, int n_in, void* d_out, int out_size, void* d_ws, size_t ws_size, hipStream_t stream) {
    static int grid = 0;
    if (grid == 0) {
        if (n_in != 36 || ws_size < WS_END) { fprintf(stderr, "kernel_launch: unexpected n_in %d / ws_size %zu (need %zu)\n", n_in, ws_size, (size_t)WS_END); grid = -1; return; }
        int dev = 0, cus = 0, per_cu = 0;
        (void)hipGetDevice(&dev); (void)hipDeviceGetAttribute(&cus, hipDeviceAttributeMultiprocessorCount, dev);
        (void)hipFuncSetAttribute((const void*)mega, hipFuncAttributeMaxDynamicSharedMemorySize, LDS_BYTES);
        if (hipOccupancyMaxActiveBlocksPerMultiprocessor(&per_cu, (const void*)mega, NTHREADS, LDS_BYTES) != hipSuccess || per_cu < 1) per_cu = 1;
        (void)hipGetLastError();
        if (per_cu > 1) per_cu = 1;
        grid = cus * per_cu; if (grid <= 0) grid = 256;
    }
    if (grid < 0) return;
    Args a{};
    for (int i = 0; i < 36; ++i) a.in[i] = (const float*)d_in[i];
    a.out = (float*)d_out; a.ws = (unsigned char*)d_ws;
#if MK_MULTI
    for (int p = 0; p < 10; ++p) { a.ph_lo = p; a.ph_hi = p + 1; hipLaunchKernelGGL(mega, dim3(grid), dim3(NTHREADS), LDS_BYTES, stream, a); }
#else
    a.ph_lo = 0; a.ph_hi = 10;
    (void)hipMemsetAsync(d_ws, 0, 16384, stream);
    void* kargs[] = {&a};
    hipError_t e = hipLaunchCooperativeKernel((const void*)mega, dim3(grid), dim3(NTHREADS), kargs, LDS_BYTES, stream);
    if (e != hipSuccess) fprintf(stderr, "cooperative launch failed: %s (grid %d)\n", hipGetErrorString(e), grid);
#endif
}
```
